# Optimizing an MI355X kernel written in HIP

```python
import math
import jax, jax.numpy as jnp
from jax import lax
import numpy as np

D_MODEL = 2048
BATCH = 2
SEQ = 16384
DEPTH = 1
DEC_BATCH = 8
DEC_SEQ = 64
PAST_LEN = 1024

CHUNK = 64
Q_BLOCK = 128
N_HEADS = 8
N_KV_HEADS = 2
HEAD_DIM = 128
GROUP = N_HEADS // N_KV_HEADS
ATTN_WIDTH = N_HEADS * HEAD_DIM
IDX_HEADS = 16
IDX_DIM = 64
TOPK_MAX = 256
GLA_HEADS = 4
GLA_DK = 128
GLA_DV = 256
GLA_KW = GLA_HEADS * GLA_DK
GLA_VW = GLA_HEADS * GLA_DV
GLA_RANK = 16
GLA_NORMALIZER = 16.0
MIX_WIDTH = ATTN_WIDTH + GLA_VW
N_MEM = 256
MEM_HEADS = 4
MEM_HEAD_DIM = 128
MEM_WIDTH = MEM_HEADS * MEM_HEAD_DIM
D_FF = 5632
N_BUCKETS = 32
MAX_DISTANCE = 128
DN_ALPHA = (2.0 * DEPTH) ** 0.25
DN_BETA = (8.0 * DEPTH) ** -0.25
LN_EPS = 1e-5
_SPLITS = (ATTN_WIDTH, N_KV_HEADS * HEAD_DIM, N_KV_HEADS * HEAD_DIM, IDX_HEADS * IDX_DIM, IDX_DIM, IDX_HEADS,
           GLA_KW, GLA_KW, GLA_VW, GLA_RANK, GLA_VW)
IN_WIDTH = (ATTN_WIDTH + 2 * N_KV_HEADS * HEAD_DIM + IDX_HEADS * IDX_DIM + IDX_DIM + IDX_HEADS
            + 2 * GLA_KW + GLA_VW + GLA_RANK + GLA_VW)

kernel_name = 'hybrid_dsa_gla_streaming_encoder_step'

F32 = jnp.float32


def post_norm(x, sub, g, b):
    h = DN_ALPHA * x.astype(F32) + sub.astype(F32)
    mu = h.mean(-1, keepdims=True)
    var = jnp.square(h - mu).mean(-1, keepdims=True)
    return ((h - mu) * lax.rsqrt(var + LN_EPS) * g.astype(F32) + b.astype(F32)).astype(x.dtype)


def swiglu(x, wg, wu, wd):
    return (jax.nn.silu(x @ wg) * (x @ wu)) @ wd


def rel_bucket(rel):
    half = N_BUCKETS // 2
    max_exact = half // 2
    ret = jnp.where(rel > 0, half, 0)
    n = jnp.abs(rel)
    nf = jnp.maximum(n, 1).astype(F32)
    large = max_exact + (jnp.log(nf / max_exact) / math.log(MAX_DISTANCE / max_exact)
                         * (half - max_exact)).astype(jnp.int32)
    large = jnp.minimum(large, half - 1)
    return ret + jnp.where(n < max_exact, n, large)


def mixer_project(x, w_in, w_a2, b_a):
    B, T = x.shape[:2]
    offs = np.cumsum(_SPLITS)[:-1].tolist()
    q, k, v, qi, ki, wi, gq, gk, gv, glr, gr = jnp.split(x @ w_in, offs, axis=-1)
    q = q.reshape(B, T, N_HEADS, HEAD_DIM)
    k = k.reshape(B, T, N_KV_HEADS, HEAD_DIM)
    v = v.reshape(B, T, N_KV_HEADS, HEAD_DIM)
    qi = qi.reshape(B, T, IDX_HEADS, IDX_DIM)
    gq = gq.reshape(B, T, GLA_HEADS, GLA_DK) * GLA_DK ** -0.5
    gk = gk.reshape(B, T, GLA_HEADS, GLA_DK)
    gv = gv.reshape(B, T, GLA_HEADS, GLA_DV)
    la = (jax.nn.log_sigmoid((glr @ w_a2 + b_a).astype(F32)) / GLA_NORMALIZER).reshape(B, T, GLA_HEADS, GLA_DK)
    return q, k, v, qi, ki, wi, gq, gk, gv, la, gr


def dsa_block(q, qi, wi, qpos, k_all, v_all, ki_all, n_sel, rel_bias):
    B, Tb = q.shape[:2]
    L = k_all.shape[1]
    limit = (qpos // CHUNK + 1) * CHUNK
    kpos = jnp.arange(L, dtype=jnp.int32)
    s = jnp.einsum('bthd,bsd->bths', qi.astype(F32), ki_all.astype(F32)) * IDX_DIM ** -0.5
    score = jnp.einsum('bths,bth->bts', jax.nn.relu(s), wi.astype(F32)) * IDX_HEADS ** -0.5
    score = jnp.where(kpos[None, None, :] < limit[None, :, None], score, -jnp.inf)
    _, idx = lax.top_k(score, n_sel)
    gather = jax.vmap(lambda rows, ii: rows[ii])
    k_sel = gather(k_all, idx)
    v_sel = gather(v_all, idx)
    valid = idx < limit[None, :, None]
    bias = rel_bias[rel_bucket(idx - qpos[None, :, None])]
    bias = bias.reshape(B, Tb, n_sel, N_KV_HEADS, GROUP).transpose(0, 1, 3, 4, 2)
    qg = q.reshape(B, Tb, N_KV_HEADS, GROUP, HEAD_DIM)
    logits = jnp.einsum('btkgd,btnkd->btkgn', qg, k_sel).astype(F32) * HEAD_DIM ** -0.5 + bias.astype(F32)
    logits = jnp.where(valid[:, :, None, None, :], logits, -jnp.inf)
    p = jax.nn.softmax(logits, axis=-1).astype(v_sel.dtype)
    o = jnp.einsum('btkgn,btnkd->btkgd', p, v_sel)
    return o.reshape(B, Tb, ATTN_WIDTH)


def dsa_prompt(q, qi, wi, k, v, ki, rel_bias):
    B, T = q.shape[:2]
    nb = T // Q_BLOCK
    n_sel = min(TOPK_MAX, T // 4)

    def blk(a):
        return jnp.moveaxis(a.reshape(B, nb, Q_BLOCK, *a.shape[2:]), 1, 0)

    pos = jnp.arange(T, dtype=jnp.int32).reshape(nb, Q_BLOCK)
    out = lax.map(lambda a: dsa_block(a[0], a[1], a[2], a[3], k, v, ki, n_sel, rel_bias),
                  (blk(q), blk(qi), blk(wi), pos))
    return jnp.moveaxis(out, 0, 1).reshape(B, T, ATTN_WIDTH)


def gla_chunked(q, k, v, la, s0, chunk):
    B, T = q.shape[:2]
    n = T // chunk

    def chunks(a):
        return jnp.moveaxis(a.astype(F32).reshape(B, n, chunk, *a.shape[2:]), 1, 0)

    causal = jnp.tril(jnp.ones((chunk, chunk), dtype=bool))

    def step(S, inp):
        qc, kc, vc, lc = inp
        b = jnp.cumsum(lc, axis=1)
        o_inter = jnp.einsum('bihk,bhkv->bihv', qc * jnp.exp(b), S)
        diff = b[:, :, None] - b[:, None, :]
        decay = jnp.exp(jnp.where(causal[None, :, :, None, None], diff, -jnp.inf))
        A = jnp.einsum('bihk,bjhk,bijhk->bijh', qc, kc, decay)
        o_intra = jnp.einsum('bijh,bjhv->bihv', A, vc)
        b_last = b[:, -1]
        S = jnp.exp(b_last)[..., None] * S + jnp.einsum('bjhk,bjhv->bhkv', kc * jnp.exp(b_last[:, None] - b), vc)
        return S, o_inter + o_intra

    S, o = lax.scan(step, s0.astype(F32), (chunks(q), chunks(k), chunks(v), chunks(la)))
    return jnp.moveaxis(o, 0, 1).reshape(B, T, GLA_HEADS, GLA_DV), S


def gla_output(o, gr, g):
    B, T = o.shape[:2]
    mu = o.mean(-1, keepdims=True)
    var = jnp.square(o - mu).mean(-1, keepdims=True)
    o = (o - mu) * lax.rsqrt(var + LN_EPS) * g.astype(F32).reshape(GLA_HEADS, GLA_DV)
    return (o.reshape(B, T, GLA_VW) * jax.nn.silu(gr.astype(F32))).astype(gr.dtype)


def mem_kv(mem, w_mk, w_mv):
    B, N = mem.shape[:2]
    return ((mem @ w_mk).reshape(B, N, MEM_HEADS, MEM_HEAD_DIM),
            (mem @ w_mv).reshape(B, N, MEM_HEADS, MEM_HEAD_DIM))


def mem_attend(x, mk, mv, w_mq, w_mo):
    B, T = x.shape[:2]
    q = (x @ w_mq).reshape(B, T, MEM_HEADS, MEM_HEAD_DIM)
    logits = jnp.einsum('bthd,bnhd->bthn', q, mk.astype(q.dtype)).astype(F32) * MEM_HEAD_DIM ** -0.5
    p = jax.nn.softmax(logits, axis=-1).astype(x.dtype)
    o = jnp.einsum('bthn,bnhd->bthd', p, mv.astype(x.dtype)).reshape(B, T, MEM_WIDTH)
    return o @ w_mo


def setup_inputs(seed: int = 0) -> dict:
    key = jax.random.key(seed)
    ks = jax.random.split(key, 32)

    def nrm(k, shape, s):
        return jax.random.normal(k, shape, F32) * s

    return {
        'x_prompt': nrm(ks[0], (BATCH, SEQ, D_MODEL), 1.0),
        'x_sample': nrm(ks[1], (DEC_BATCH, DEC_SEQ, D_MODEL), 1.0),
        'cache_k': nrm(ks[2], (DEPTH, DEC_BATCH, PAST_LEN, N_KV_HEADS, HEAD_DIM), 1.0),
        'cache_v': nrm(ks[3], (DEPTH, DEC_BATCH, PAST_LEN, N_KV_HEADS, HEAD_DIM), 1.0),
        'cache_idx_k': nrm(ks[4], (DEPTH, DEC_BATCH, PAST_LEN, IDX_DIM), 1.0),
        'state_gla': nrm(ks[5], (DEPTH, DEC_BATCH, GLA_HEADS, GLA_DK, GLA_DV), 1.0),
        'cache_mem_k': nrm(ks[6], (DEPTH, DEC_BATCH, N_MEM, MEM_HEADS, MEM_HEAD_DIM), 1.0),
        'cache_mem_v': nrm(ks[7], (DEPTH, DEC_BATCH, N_MEM, MEM_HEADS, MEM_HEAD_DIM), 1.0),
        'mem_prompt': nrm(ks[8], (BATCH, N_MEM, D_MODEL), 1.0),
        'rel_bias': nrm(ks[9], (N_BUCKETS, N_HEADS), 0.5),
        'ln_g': 1.0 + nrm(ks[10], (DEPTH, 4, D_MODEL), 0.02),
        'ln_b': nrm(ks[11], (DEPTH, 4, D_MODEL), 0.02),
        'ffn1_wg': nrm(ks[12], (DEPTH, D_MODEL, D_FF), D_MODEL ** -0.5),
        'ffn1_wu': nrm(ks[13], (DEPTH, D_MODEL, D_FF), D_MODEL ** -0.5),
        'ffn1_wd': nrm(ks[14], (DEPTH, D_FF, D_MODEL), D_FF ** -0.5 * DN_BETA),
        'w_in': nrm(ks[15], (DEPTH, D_MODEL, IN_WIDTH), D_MODEL ** -0.5),
        'w_a2': nrm(ks[16], (DEPTH, GLA_RANK, GLA_KW), GLA_RANK ** -0.5),
        'b_a': nrm(ks[17], (DEPTH, GLA_KW), 0.1),
        'gla_norm_g': 1.0 + nrm(ks[18], (DEPTH, GLA_VW), 0.02),
        'w_o': nrm(ks[19], (DEPTH, MIX_WIDTH, D_MODEL), MIX_WIDTH ** -0.5 * DN_BETA),
        'w_mq': nrm(ks[20], (DEPTH, D_MODEL, MEM_WIDTH), D_MODEL ** -0.5),
        'w_mk': nrm(ks[21], (DEPTH, D_MODEL, MEM_WIDTH), D_MODEL ** -0.5),
        'w_mv': nrm(ks[22], (DEPTH, D_MODEL, MEM_WIDTH), D_MODEL ** -0.5),
        'w_mo': nrm(ks[23], (DEPTH, MEM_WIDTH, D_MODEL), MEM_WIDTH ** -0.5 * DN_BETA),
        'ffn2_wg': nrm(ks[24], (DEPTH, D_MODEL, D_FF), D_MODEL ** -0.5),
        'ffn2_wu': nrm(ks[25], (DEPTH, D_MODEL, D_FF), D_MODEL ** -0.5),
        'ffn2_wd': nrm(ks[26], (DEPTH, D_FF, D_MODEL), D_FF ** -0.5 * DN_BETA),
    }


def reference(x_prompt, x_sample, cache_k, cache_v, cache_idx_k, state_gla, cache_mem_k, cache_mem_v,
              mem_prompt, rel_bias, ln_g, ln_b, ffn1_wg, ffn1_wu, ffn1_wd, w_in, w_a2, b_a, gla_norm_g,
              w_o, w_mq, w_mk, w_mv, w_mo, ffn2_wg, ffn2_wu, ffn2_wd):
    xp, xs = x_prompt, x_sample
    Bp = xp.shape[0]
    Bs, Ts = xs.shape[:2]
    P = cache_k.shape[2]
    L_s = P + Ts
    n_sel_s = min(TOPK_MAX, L_s // 4)
    qpos_s = P + jnp.arange(Ts, dtype=jnp.int32)
    pk, pv, pki, pS, pmk, pmv = [], [], [], [], [], []
    sk, sv, ski, sS = [], [], [], []
    for l in range(DEPTH):
        xp = post_norm(xp, 0.5 * swiglu(xp, ffn1_wg[l], ffn1_wu[l], ffn1_wd[l]), ln_g[l, 0], ln_b[l, 0])
        xs = post_norm(xs, 0.5 * swiglu(xs, ffn1_wg[l], ffn1_wu[l], ffn1_wd[l]), ln_g[l, 0], ln_b[l, 0])

        q, k, v, qi, ki, wi, gq, gk, gv, la, gr = mixer_project(xp, w_in[l], w_a2[l], b_a[l])
        attn = dsa_prompt(q, qi, wi, k, v, ki, rel_bias)
        s0 = jnp.zeros((Bp, GLA_HEADS, GLA_DK, GLA_DV), F32)
        go, S_p = gla_chunked(gq, gk, gv, la, s0, CHUNK)
        mix = jnp.concatenate([attn, gla_output(go, gr, gla_norm_g[l])], axis=-1) @ w_o[l]
        xp = post_norm(xp, mix, ln_g[l, 1], ln_b[l, 1])
        pk.append(k); pv.append(v); pki.append(ki); pS.append(S_p.astype(state_gla.dtype))

        q, k, v, qi, ki, wi, gq, gk, gv, la, gr = mixer_project(xs, w_in[l], w_a2[l], b_a[l])
        k_all = jnp.concatenate([cache_k[l].astype(k.dtype), k], axis=1)
        v_all = jnp.concatenate([cache_v[l].astype(v.dtype), v], axis=1)
        ki_all = jnp.concatenate([cache_idx_k[l].astype(ki.dtype), ki], axis=1)
        attn = dsa_block(q, qi, wi, qpos_s, k_all, v_all, ki_all, n_sel_s, rel_bias)
        go, S_s = gla_chunked(gq, gk, gv, la, state_gla[l], Ts)
        mix = jnp.concatenate([attn, gla_output(go, gr, gla_norm_g[l])], axis=-1) @ w_o[l]
        xs = post_norm(xs, mix, ln_g[l, 1], ln_b[l, 1])
        sk.append(k); sv.append(v); ski.append(ki); sS.append(S_s.astype(state_gla.dtype))

        mk_p, mv_p = mem_kv(mem_prompt, w_mk[l], w_mv[l])
        xp = post_norm(xp, mem_attend(xp, mk_p, mv_p, w_mq[l], w_mo[l]), ln_g[l, 2], ln_b[l, 2])
        xs = post_norm(xs, mem_attend(xs, cache_mem_k[l], cache_mem_v[l], w_mq[l], w_mo[l]), ln_g[l, 2], ln_b[l, 2])
        pmk.append(mk_p); pmv.append(mv_p)

        xp = post_norm(xp, 0.5 * swiglu(xp, ffn2_wg[l], ffn2_wu[l], ffn2_wd[l]), ln_g[l, 3], ln_b[l, 3])
        xs = post_norm(xs, 0.5 * swiglu(xs, ffn2_wg[l], ffn2_wu[l], ffn2_wd[l]), ln_g[l, 3], ln_b[l, 3])

    return (xp, xs,
            jnp.stack(pk), jnp.stack(pv), jnp.stack(pki), jnp.stack(pS), jnp.stack(pmk), jnp.stack(pmv),
            jnp.stack(sk), jnp.stack(sv), jnp.stack(ski), jnp.stack(sS))
```

```cpp
#include <hip/hip_runtime.h>
#include <hip/hip_cooperative_groups.h>
#include <cstdio>
#include <cstdint>
namespace cg = cooperative_groups;

#define LAS __attribute__((address_space(3)))
typedef _Float16 h16;
typedef _Float16 h16x8 __attribute__((ext_vector_type(8)));
typedef _Float16 h16x4 __attribute__((ext_vector_type(4)));
typedef _Float16 h16x2 __attribute__((ext_vector_type(2)));
typedef float f32x4 __attribute__((ext_vector_type(4)));
typedef float f32x2 __attribute__((ext_vector_type(2)));
typedef unsigned u32x4 __attribute__((ext_vector_type(4)));
typedef unsigned u32x2 __attribute__((ext_vector_type(2)));

constexpr int DM = 2048, NP = 32768, NS = 512, MT = NP + NS  , DFF = 5632;
constexpr int SEQ = 16384, PAST = 1024;
constexpr int PW = 5888;
constexpr int C_Q = 0, C_K = 1024, C_V = 1280, C_QI = 1536, C_KI = 2560, C_WI = 2624, C_GLR = 2640, C_GQ = 2816, C_GK = 3328, C_GV = 3840, C_GR = 4864;
constexpr float DN_ALPHA = 1.189207115002721f;
constexpr float LN_EPS = 1e-5f;
constexpr float RS128 = 0.08838834764831845f;

constexpr size_t O_Y = 0;
constexpr size_t O_KP = (size_t)MT * DM;
constexpr size_t O_VP = O_KP + (size_t)NP * 256;
constexpr size_t O_KIP = O_VP + (size_t)NP * 256;
constexpr size_t O_SP = O_KIP + (size_t)NP * 64;
constexpr size_t O_MKP = O_SP + (size_t)2 * 4 * 128 * 256;
constexpr size_t O_MVP = O_MKP + (size_t)2 * 256 * 512;
constexpr size_t O_KS = O_MVP + (size_t)2 * 256 * 512;
constexpr size_t O_VS = O_KS + (size_t)NS * 256;
constexpr size_t O_KIS = O_VS + (size_t)NS * 256;
constexpr size_t O_SS = O_KIS + (size_t)NS * 64;
constexpr size_t O_END = O_SS + (size_t)8 * 4 * 128 * 256;
static_assert(O_END == 89161728, "out size");

constexpr size_t WS_CTL = 0;
constexpr size_t WS_WUP1 = 4096;
constexpr size_t WS_WDN1 = WS_WUP1 + (size_t)2 * DFF * DM * 2;
constexpr size_t WS_WUP2 = WS_WDN1 + (size_t)DM * DFF * 2;
constexpr size_t WS_WDN2 = WS_WUP2 + (size_t)2 * DFF * DM * 2;
constexpr size_t WS_WIN = WS_WDN2 + (size_t)DM * DFF * 2;
constexpr size_t WS_WO = WS_WIN + (size_t)PW * DM * 2;
constexpr size_t WS_WMQ = WS_WO + (size_t)DM * DM * 2;
constexpr size_t WS_WMO = WS_WMQ + (size_t)512 * DM * 2;
constexpr size_t WS_WMKV = WS_WMO + (size_t)DM * 512 * 2;
constexpr size_t WS_X = WS_WMKV + (size_t)1024 * DM * 2;
constexpr size_t WS_HP = WS_X + (size_t)MT * DM * 2;
constexpr size_t WS_MIX = WS_HP + (size_t)MT * PW * 2;
constexpr size_t WS_QT = WS_MIX + (size_t)MT * DM * 2;
constexpr size_t WS_KT = WS_QT + (size_t)MT * 512 * 2;
constexpr size_t WS_KTT = WS_KT + (size_t)MT * 512 * 2;
constexpr size_t WS_VT = WS_KTT + (size_t)MT * 512 * 2;
constexpr size_t WS_ER = WS_VT + (size_t)MT * 1024 * 2;
constexpr size_t WS_DEC = WS_ER + (size_t)520 * 512 * 4;
constexpr size_t WS_FF = WS_DEC + (size_t)520 * 512 * 4;
constexpr size_t WS_MEMH = WS_FF + (size_t)520 * 512 * 4;
constexpr size_t WS_MK16 = WS_MEMH + (size_t)512 * DM * 2;
constexpr size_t WS_MVT = WS_MK16 + (size_t)512 * 512 * 2;
constexpr size_t WS_CK = WS_MVT + (size_t)512 * 512 * 2;
constexpr size_t WS_CV = WS_CK + (size_t)8192 * 256 * 2;
constexpr size_t WS_CKI = WS_CV + (size_t)8192 * 256 * 2;
constexpr size_t WS_CMK = WS_CKI + (size_t)8192 * 64 * 2;
constexpr size_t WS_CMVT = WS_CMK + (size_t)2048 * 512 * 2;
constexpr size_t WS_PART = WS_CMVT + (size_t)2048 * 512 * 2;
constexpr size_t WS_BAR = WS_PART + (size_t)4 * NS * DM * 4;
constexpr size_t WS_END = WS_BAR + 16384;
constexpr size_t WS_KVC = WS_WUP1;
constexpr size_t WS_KIC = WS_KVC + (size_t)MT * 512 * 2;
constexpr size_t WS_KC8 = WS_KIC + (size_t)MT * 64 * 2;
static_assert(WS_KC8 + (size_t)MT * 256 <= WS_WUP2, "compact tables overlay (dead FFN1 weight copies)");
constexpr size_t WS_VC8 = WS_KC8 + (size_t)MT * 256;
static_assert(WS_VC8 + (size_t)MT * 256 <= WS_WUP2, "compact tables overlay");
constexpr size_t WS_CV8 = WS_BAR + 16384 + (size_t)8192 * 256;
static_assert(WS_CV8 + (size_t)8192 * 256 <= (size_t)1073741824, "ws map");
constexpr size_t WS_CK8 = WS_BAR + 16384;
static_assert(WS_CK8 + (size_t)8192 * 256 <= (size_t)1073741824, "ws map");
constexpr size_t WS_MQ = WS_QT;
constexpr size_t WS_MO = WS_KT;
static_assert(WS_END <= (size_t)1073741824, "ws map");

constexpr int LDS_BYTES = 155648;

struct Args { const float* in[27]; float* out; unsigned char* ws; };

__device__ __forceinline__ float wave_sum(float v) {
#pragma unroll
    for (int o = 1; o < 64; o <<= 1) v += __shfl_xor(v, o);
    return v;
}
__device__ __forceinline__ float wave_max(float v) {
#pragma unroll
    for (int o = 1; o < 64; o <<= 1) v = fmaxf(v, __shfl_xor(v, o));
    return v;
}
#define LDS_WAIT() asm volatile("s_waitcnt lgkmcnt(0)" ::: "memory")
__device__ __forceinline__ int opaque_tid(int wv) { int t = wv * 64 + (int)__builtin_amdgcn_mbcnt_hi(~0u, __builtin_amdgcn_mbcnt_lo(~0u, 0u)); asm volatile("" : "+v"(t)); return t; }

__device__ __forceinline__ u32x2 pack_fp8x8(const f32x4 a, const f32x4 b) {
    int lo = 0, hi = 0;
    lo = __builtin_amdgcn_cvt_pk_fp8_f32(a[0], a[1], lo, false); lo = __builtin_amdgcn_cvt_pk_fp8_f32(a[2], a[3], lo, true);
    hi = __builtin_amdgcn_cvt_pk_fp8_f32(b[0], b[1], hi, false); hi = __builtin_amdgcn_cvt_pk_fp8_f32(b[2], b[3], hi, true);
    u32x2 r; r[0] = (unsigned)lo; r[1] = (unsigned)hi; return r;
}
namespace pg8 {
constexpr int BM = 256, BK = 64, HALF = 128, HTB = HALF * BK * 2, STAGE_BYTES = 8 * HTB, NXCD = 8, WGM = 8;
__device__ __forceinline__ int lds_byte(int r, int c) { const int st = (r >> 4) * 2 + (c >> 5), rr = r & 15, cc = c & 31, ob = rr * 64 + cc * 2; return st * 1024 + (ob ^ (((ob >> 9) & 1) << 5)); }
__device__ __forceinline__ void stage_rc(int b, int& R, int& C) { const int st = b / 1024, sb = b % 1024, swz = sb ^ (((sb >> 9) & 1) << 5); R = (st >> 1) * 16 + swz / 64; C = (st & 1) * 32 + (swz % 64) / 2; }
__device__ __forceinline__ int perm32(int rho) { const int n = rho >> 4, i = rho & 15; return 8 * (i >> 2) + 4 * n + (i & 3); }
struct Unit { int pm, pn, nt, ks; size_t koff; };
struct Gemm { const h16* A; const h16* Bt; int M, N, K; };
struct StaticOrder {
    int nM, nN, nwg, G, c;
    __device__ void init(int M, int N, int G_, int c_) { nM = M / BM; nN = N / BM; nwg = nM * nN; G = G_; c = c_; kt = 0; }
    __device__ bool next(int i, Unit& u) const {
        const long L = (long)i * G + c; if (L >= nwg) return false;
        int wgid = (int)L; { const int q = nwg / NXCD, r = nwg % NXCD, xcd = wgid % NXCD, off = wgid / NXCD; wgid = (xcd < r ? xcd * (q + 1) : r * (q + 1) + (xcd - r) * q) + off; }
        const int nig = WGM * nN, gid = wgid / nig, fm = gid * WGM, gsz = (nM - fm) < WGM ? (nM - fm) : WGM;
        u.pm = fm + ((wgid % nig) % gsz); u.pn = (wgid % nig) / gsz; u.nt = kt; u.ks = -1; u.koff = 0; return true;
    }
    int kt;
};
struct SplitTailOrder {
    StaticOrder P; int G, c, K;
    __device__ void init(int K_, int G_, int c_) { P.init(NP, 2048, G_, c_); P.kt = K_ / BK; G = G_; c = c_; K = K_; }
    __device__ bool next(int i, Unit& u) const {
        if (P.next(i, u)) return true;
        const long L = (long)i * G + c - P.nwg; if (L < 0 || L >= 64) return false;
        const int j = (int)L; u.pm = 128 + (j >> 5); u.pn = (j >> 2) & 7; u.ks = j & 3; u.nt = K / BK / 4; u.koff = (size_t)u.ks * (K / 4) * 2; return true;
    }
};
__device__ __forceinline__ u32x4 pack8(const f32x4 a, const f32x4 b) {
    h16x8 h; h[0] = (h16)a[0]; h[1] = (h16)a[1]; h[2] = (h16)a[2]; h[3] = (h16)a[3]; h[4] = (h16)b[0]; h[5] = (h16)b[1]; h[6] = (h16)b[2]; h[7] = (h16)b[3];
    return __builtin_bit_cast(u32x4, h);
}
struct EpiSwiglu {
    h16* H;
    __device__ __forceinline__ void operator()(const f32x4 (&acc)[2][2][4][2], const Unit& u, int wr, int wc, int fr, int fq) const {
        const int row0 = u.pm * BM + wr * 64 + fr, col0 = u.pn * 128 + wc * 32 + 8 * fq;
#pragma unroll
        for (int ai = 0; ai < 2; ++ai)
#pragma unroll
            for (int m = 0; m < 4; ++m) {
                f32x4 o[2];
#pragma unroll
                for (int n = 0; n < 2; ++n)
#pragma unroll
                    for (int j = 0; j < 4; ++j) { const float g = acc[ai][0][m][n][j], up = acc[ai][1][m][n][j]; o[n][j] = g * __builtin_amdgcn_rcpf(1.f + __expf(-g)) * up; }
                *(u32x4*)(H + (size_t)(row0 + ai * HALF + m * 16) * DFF + col0) = pack8(o[0], o[1]);
            }
    }
};
struct EpiRes {
    h16* X; float alpha, beta; float* part;
    __device__ __forceinline__ void operator()(const f32x4 (&acc)[2][2][4][2], const Unit& u, int wr, int wc, int fr, int fq) const {
        const int row0 = u.pm * BM + wr * 64 + fr, col0 = u.pn * BM + wc * 32 + 8 * fq;
        if (u.ks >= 0) {
#pragma unroll
            for (int ai = 0; ai < 2; ++ai)
#pragma unroll
                for (int m = 0; m < 4; ++m)
#pragma unroll
                    for (int bj = 0; bj < 2; ++bj) { float* d = part + ((size_t)u.ks * NS + (row0 + ai * HALF + m * 16 - NP)) * DM + col0 + bj * HALF;
                        *(f32x4*)d = acc[ai][bj][m][0]; *(f32x4*)(d + 4) = acc[ai][bj][m][1]; }
            return;
        }
#pragma unroll
        for (int ai = 0; ai < 2; ++ai) {
            u32x4 res[4][2];
#pragma unroll
            for (int m = 0; m < 4; ++m)
#pragma unroll
                for (int bj = 0; bj < 2; ++bj) res[m][bj] = *(const u32x4*)(X + (size_t)(row0 + ai * HALF + m * 16) * DM + col0 + bj * HALF);
#pragma unroll
            for (int m = 0; m < 4; ++m)
#pragma unroll
                for (int bj = 0; bj < 2; ++bj) {
                    h16* p = X + (size_t)(row0 + ai * HALF + m * 16) * DM + col0 + bj * HALF;
                    const h16x8 r = __builtin_bit_cast(h16x8, res[m][bj]);
                    f32x4 o0, o1;
#pragma unroll
                    for (int j = 0; j < 4; ++j) { o0[j] = alpha * (float)r[j] + beta * acc[ai][bj][m][0][j]; o1[j] = alpha * (float)r[4 + j] + beta * acc[ai][bj][m][1][j]; }
                    *(u32x4*)p = pack8(o0, o1);
                }
        }
    }
};
struct EpiPlain {
    h16* O; int ld;
    __device__ __forceinline__ void operator()(const f32x4 (&acc)[2][2][4][2], const Unit& u, int wr, int wc, int fr, int fq) const {
        const int row0 = u.pm * BM + wr * 64 + fr, col0 = u.pn * BM + wc * 32 + 8 * fq;
#pragma unroll
        for (int ai = 0; ai < 2; ++ai)
#pragma unroll
            for (int m = 0; m < 4; ++m)
#pragma unroll
                for (int bj = 0; bj < 2; ++bj)
                    *(u32x4*)(O + (size_t)(row0 + ai * HALF + m * 16) * ld + col0 + bj * HALF) = pack8(acc[ai][bj][m][0], acc[ai][bj][m][1]);
    }
};
struct EpiProj {
    h16* O; float* out; h16* KVC; h16* KIC; unsigned char* KC8; unsigned char* VC8;
    __device__ __forceinline__ void operator()(const f32x4 (&acc)[2][2][4][2], const Unit& u, int wr, int wc, int fr, int fq) const {
        const int row0 = u.pm * BM + wr * 64 + fr, col0 = u.pn * BM + wc * 32 + 8 * fq;
        const bool prompt = u.pm < 128;
#pragma unroll
        for (int ai = 0; ai < 2; ++ai)
#pragma unroll
            for (int m = 0; m < 4; ++m)
#pragma unroll
                for (int bj = 0; bj < 2; ++bj) {
                    const int row = row0 + ai * HALF + m * 16, col = col0 + bj * HALF;
                    *(u32x4*)(O + (size_t)row * PW + col) = pack8(acc[ai][bj][m][0], acc[ai][bj][m][1]);
                    float* d = nullptr;
                    const int rr = prompt ? row : row - NP;
                    if (u.pn == 4) { d = out + (prompt ? O_KP : O_KS) + (size_t)rr * 256 + (col - C_K); *(u32x2*)(KC8 + (size_t)row * 256 + (col - C_K)) = pack_fp8x8(acc[ai][bj][m][0], acc[ai][bj][m][1]); }
                    else if (u.pn == 5) { d = out + (prompt ? O_VP : O_VS) + (size_t)rr * 256 + (col - C_V); *(u32x2*)(VC8 + (size_t)row * 256 + (col - C_V)) = pack_fp8x8(acc[ai][bj][m][0], acc[ai][bj][m][1]); }
                    else if (u.pn == 10 && col < C_KI + 64) { d = out + (prompt ? O_KIP : O_KIS) + (size_t)rr * 64 + (col - C_KI); *(u32x4*)(KIC + (size_t)row * 64 + (col - C_KI)) = pack8(acc[ai][bj][m][0], acc[ai][bj][m][1]); }
                    if (d) { *(f32x4*)d = acc[ai][bj][m][0]; *(f32x4*)(d + 4) = acc[ai][bj][m][1]; }
                }
    }
};
struct EpiMemKV {
    float* out; h16* MK; h16* MVT;
    __device__ __forceinline__ void operator()(const f32x4 (&acc)[2][2][4][2], const Unit& u, int wr, int wc, int fr, int fq) const {
        const int row0 = u.pm * BM + wr * 64 + fr, col0 = u.pn * BM + wc * 32 + 8 * fq;
#pragma unroll
        for (int ai = 0; ai < 2; ++ai)
#pragma unroll
            for (int m = 0; m < 4; ++m)
#pragma unroll
                for (int bj = 0; bj < 2; ++bj) {
                    const int row = row0 + ai * HALF + m * 16, col = col0 + bj * HALF;
                    if (col < 512) {
                        float* d = out + O_MKP + (size_t)row * 512 + col;
                        *(f32x4*)d = acc[ai][bj][m][0]; *(f32x4*)(d + 4) = acc[ai][bj][m][1];
                        *(u32x4*)(MK + (size_t)row * 512 + col) = pack8(acc[ai][bj][m][0], acc[ai][bj][m][1]);
                    } else {
                        const int c2 = col - 512;
                        float* d = out + O_MVP + (size_t)row * 512 + c2;
                        *(f32x4*)d = acc[ai][bj][m][0]; *(f32x4*)(d + 4) = acc[ai][bj][m][1];
                        const int b = row >> 8, nn = row & 255;
#pragma unroll
                        for (int n = 0; n < 2; ++n)
#pragma unroll
                            for (int j = 0; j < 4; ++j) { const int cc = c2 + 4 * n + j; MVT[((size_t)(b * 4 + (cc >> 7)) * 128 + (cc & 127)) * 256 + nn] = (h16)acc[ai][bj][m][n][j]; }
                    }
                }
    }
};

template <class Epi, class Order>
__device__ __forceinline__ void gemm_phase(int wv, LAS unsigned char* lds, const Gemm g, const Order& S, const Epi& E) {
    const int tid = opaque_tid(wv), wid = __builtin_amdgcn_readfirstlane(tid >> 6), lane = tid & 63, wr = wid >> 2, wc = wid & 3, fr = lane & 15, fq = lane >> 4;
    const int K = g.K;
    unsigned voffA[2], voffB[2];
#pragma unroll
    for (int i = 0; i < 2; ++i) { int R, C; stage_rc(tid * 16 + i * 8192, R, C); const int Rb = (R & ~31) + perm32(R & 31);
        voffA[i] = (unsigned)(R * K + C) * 2u; voffB[i] = (unsigned)(Rb * K + C) * 2u; }
    const size_t kstep = (size_t)(BK * 2);
    const size_t hstep = (size_t)HALF * K * 2;
    const size_t tstep = 2 * hstep;
    const unsigned ldsw = (unsigned)wid * 1024u;
    const int aoff = lds_byte(wr * 64 + fr, fq * 8), boff = lds_byte(wc * 32 + fr, fq * 8);
#define PG8_SA(b, h) (((b) * 2 + (h)) * HTB)
#define PG8_SB(b, h) ((4 + (b) * 2 + (h)) * HTB)
#define PG8_STAGE(bufoff, gbase, voff) do { _Pragma("unroll") for (int _i = 0; _i < 2; ++_i) \
        __builtin_amdgcn_global_load_lds((const unsigned*)((const char*)(gbase) + (voff)[_i]), (LAS unsigned*)(lds + (bufoff) + ldsw + _i * 8192), 16, 0, 0); } while (0)
#define PG8_LDA(dst, b, h) do { _Pragma("unroll") for (int m = 0; m < 4; ++m) _Pragma("unroll") for (int k = 0; k < 2; ++k) dst[m][k] = *(const LAS h16x8*)(lds + PG8_SA(b, h) + aoff + m * 2048 + k * 1024); } while (0)
#define PG8_LDB(dst, b, h) do { _Pragma("unroll") for (int n = 0; n < 2; ++n) _Pragma("unroll") for (int k = 0; k < 2; ++k) dst[n][k] = *(const LAS h16x8*)(lds + PG8_SB(b, h) + boff + n * 2048 + k * 1024); } while (0)
#define PG8_MMA(ai, bj, At, Bt) do { __builtin_amdgcn_s_setprio(1); _Pragma("unroll") for (int m = 0; m < 4; ++m) _Pragma("unroll") for (int n = 0; n < 2; ++n) _Pragma("unroll") for (int k = 0; k < 2; ++k) \
        acc[ai][bj][m][n] = __builtin_amdgcn_mfma_f32_16x16x32_f16(Bt[n][k], At[m][k], acc[ai][bj][m][n], 0, 0, 0); __builtin_amdgcn_s_setprio(0); } while (0)
#define PG8_WAIT_V(n) asm volatile("s_waitcnt vmcnt(" #n ")" ::: "memory")
#define PG8_WAIT_L(n) asm volatile("s_waitcnt lgkmcnt(" #n ")" ::: "memory")
#define PG8_BAR __builtin_amdgcn_s_barrier()
#define PG8_SCHED __builtin_amdgcn_sched_barrier(0)
    Unit cur, nxt; int ui = 0;
    if (!S.next(0, cur)) return;
    f32x4 acc[2][2][4][2];
#pragma unroll
    for (int a = 0; a < 2; ++a)
#pragma unroll
        for (int b = 0; b < 2; ++b)
#pragma unroll
            for (int m = 0; m < 4; ++m)
#pragma unroll
                for (int n = 0; n < 2; ++n) acc[a][b][m][n] = (f32x4){0.f, 0.f, 0.f, 0.f};
    h16x8 At[4][2], B0[2][2], B1[2][2];
    const char* cA = (const char*)g.A + (size_t)cur.pm * tstep + cur.koff; const char* cB = (const char*)g.Bt + (size_t)cur.pn * tstep + cur.koff;
    PG8_STAGE(PG8_SB(0, 0), cB, voffB); PG8_STAGE(PG8_SB(0, 1), cB + hstep, voffB); PG8_STAGE(PG8_SA(0, 0), cA, voffA); PG8_STAGE(PG8_SA(0, 1), cA + hstep, voffA);
    if (wr == 1) PG8_BAR;
    PG8_WAIT_V(2); PG8_BAR;
    PG8_STAGE(PG8_SB(1, 0), cB + kstep, voffB); PG8_STAGE(PG8_SA(1, 0), cA + kstep, voffA); PG8_STAGE(PG8_SB(1, 1), cB + hstep + kstep, voffB);
    PG8_WAIT_V(6); PG8_BAR;
    for (;;) {
        const bool has_next = S.next(ui + 1, nxt);
        const char* nA = has_next ? (const char*)g.A + (size_t)nxt.pm * tstep + nxt.koff : cA; const char* nB = has_next ? (const char*)g.Bt + (size_t)nxt.pn * tstep + nxt.koff : cB;
        const int nt = cur.nt;
        for (int t = 0; t < nt; t += 2) {
            const bool last = (t == nt - 2);
            const char* a1 = cA + (size_t)(t + 1) * kstep;
            const char* a2 = last ? nA : cA + (size_t)(t + 2) * kstep; const char* b2 = last ? nB : cB + (size_t)(t + 2) * kstep;
            const char* a3 = a2 + kstep; const char* b3 = b2 + kstep;
            PG8_LDB(B0, 0, 0); PG8_LDB(B1, 0, 1); PG8_SCHED; PG8_LDA(At, 0, 0); PG8_STAGE(PG8_SA(1, 1), a1 + hstep, voffA);
            PG8_WAIT_V(8); PG8_WAIT_L(0); PG8_BAR; PG8_MMA(0, 0, At, B0); PG8_MMA(0, 1, At, B1); PG8_BAR; PG8_SCHED;
            PG8_LDA(At, 0, 1); PG8_STAGE(PG8_SB(0, 0), b2, voffB); PG8_STAGE(PG8_SB(0, 1), b2 + hstep, voffB); PG8_STAGE(PG8_SA(0, 0), a2, voffA);
            PG8_WAIT_V(8); PG8_WAIT_L(0); PG8_BAR; PG8_MMA(1, 0, At, B0); PG8_MMA(1, 1, At, B1); PG8_BAR; PG8_SCHED;
            PG8_LDB(B0, 1, 0); PG8_LDB(B1, 1, 1); PG8_SCHED; PG8_LDA(At, 1, 0); PG8_STAGE(PG8_SA(0, 1), a2 + hstep, voffA);
            PG8_WAIT_V(8); PG8_WAIT_L(0); PG8_BAR; PG8_MMA(0, 0, At, B0); PG8_MMA(0, 1, At, B1); PG8_BAR; PG8_SCHED;
            PG8_LDA(At, 1, 1); PG8_STAGE(PG8_SB(1, 0), b3, voffB); PG8_STAGE(PG8_SB(1, 1), b3 + hstep, voffB); PG8_STAGE(PG8_SA(1, 0), a3, voffA);
            PG8_WAIT_V(8); PG8_WAIT_L(0); PG8_BAR; PG8_MMA(1, 0, At, B0); PG8_MMA(1, 1, At, B1); PG8_BAR; PG8_SCHED;
        }
        if (wr == 0) PG8_BAR;
        E(acc, cur, wr, wc, fr, fq);
        if (!has_next) break;
#pragma unroll
        for (int a = 0; a < 2; ++a)
#pragma unroll
            for (int b = 0; b < 2; ++b)
#pragma unroll
                for (int m = 0; m < 4; ++m)
#pragma unroll
                    for (int n = 0; n < 2; ++n) acc[a][b][m][n] = (f32x4){0.f, 0.f, 0.f, 0.f};
        cur = nxt; cA = nA; cB = nB; ++ui;
        if (wr == 1) PG8_BAR;
    }
    PG8_WAIT_V(0);
    PG8_BAR;
#undef PG8_SA
#undef PG8_SB
#undef PG8_STAGE
#undef PG8_LDA
#undef PG8_LDB
#undef PG8_MMA
#undef PG8_WAIT_V
#undef PG8_WAIT_L
#undef PG8_BAR
#undef PG8_SCHED
}
}

__device__ __forceinline__ void tr_item(const float* colp, int ld, float sc, int K, h16* WT, LAS float* scr, int k0, int n0, int lane) {
    const int cg = lane & 15;
#pragma unroll
    for (int i = 0; i < 16; ++i) { const int kk = 4 * i + (lane >> 4);
        f32x4 v = {0.f, 0.f, 0.f, 0.f}; if (colp) v = *(const f32x4*)(colp + (size_t)(k0 + kk) * ld) * sc;
        LAS float* d = scr + kk * 65 + 4 * cg; d[0] = v[0]; d[1] = v[1]; d[2] = v[2]; d[3] = v[3]; }
    LDS_WAIT(); asm volatile("" ::: "memory");
    const int c = lane & 7;
#pragma unroll
    for (int j = 0; j < 8; ++j) { const int n = (lane >> 3) + 8 * j; const LAS float* s = scr + (8 * c) * 65 + n;
        h16x8 o;
#pragma unroll
        for (int e = 0; e < 8; ++e) o[e] = (h16)s[e * 65];
        *(u32x4*)(WT + (size_t)(n0 + n) * K + k0 + 8 * c) = __builtin_bit_cast(u32x4, o); }
    LDS_WAIT(); asm volatile("" ::: "memory");
}
__device__ __forceinline__ void cvt_copy(const float* src, h16* dst, size_t n8, size_t gt, size_t ngt) {
    for (size_t i = gt; i < n8; i += ngt) { const f32x4 a = *(const f32x4*)(src + i * 8), b = *(const f32x4*)(src + i * 8 + 4); *(u32x4*)(dst + i * 8) = pg8::pack8(a, b); }
}
__device__ __forceinline__ void p0_convert(int wv, const Args& A, LAS unsigned char* lds, int G) {
    const int tid = opaque_tid(wv), lane = tid & 63, wave = tid >> 6;
    unsigned char* ws = A.ws;
    LAS float* scr = (LAS float*)(lds + wave * 16640);
    const int gw = blockIdx.x * 8 + wave, NGW = G * 8;
    constexpr int I_UP = 32 * 176, I_DN = 88 * 32, I_IN = 32 * 92, I_O = 32 * 32, I_MQ = 32 * 8, I_MO = 8 * 32, I_MKV = 32 * 16;
    constexpr int NITEMS = 2 * (I_UP + I_DN) + I_IN + I_O + I_MQ + I_MO + I_MKV;
    for (int it = gw; it < NITEMS; it += NGW) {
        int r = it; const float* colp = nullptr; int ld = 0, K = 2048, nblk = 1; float sc = 1.f; h16* WT = nullptr;
        int mode;
        if (r < I_UP) mode = 0; else if ((r -= I_UP) < I_DN) mode = 1; else if ((r -= I_DN) < I_UP) mode = 2; else if ((r -= I_UP) < I_DN) mode = 3;
        else if ((r -= I_DN) < I_IN) mode = 4; else if ((r -= I_IN) < I_O) mode = 5; else if ((r -= I_O) < I_MQ) mode = 6; else if ((r -= I_MQ) < I_MO) mode = 7; else { r -= I_MO; mode = 8; }
        switch (mode) { case 0: case 2: nblk = 176; break; case 1: case 3: nblk = 32; K = DFF; break; case 4: nblk = 92; break; case 5: nblk = 32; break; case 6: nblk = 8; break; case 7: nblk = 32; K = 512; break; default: nblk = 16; break; }
        const int kb = r / nblk, nb = r % nblk, k0 = 64 * kb, n0 = 64 * nb, n = n0 + 4 * (lane & 15);
        switch (mode) {
            case 0: case 2: { const int pn = n >> 8, w = n & 255; colp = A.in[(mode == 0 ? 12 : 24) + (w < 128 ? 0 : 1)] + 128 * pn + (w & 127); ld = DFF; WT = (h16*)(ws + (mode == 0 ? WS_WUP1 : WS_WUP2)); break; }
            case 1: case 3: colp = A.in[mode == 1 ? 14 : 26] + n; ld = DM; WT = (h16*)(ws + (mode == 1 ? WS_WDN1 : WS_WDN2)); break;
            case 4: { int oc;
                if (n < C_GLR) oc = n; else if (n < C_GLR + 16) oc = 4688 + (n - C_GLR); else if (n < C_GQ) oc = -1; else if (n < C_GK) oc = 2640 + (n - C_GQ);
                else if (n < C_GV) oc = 3152 + (n - C_GK); else if (n < C_GR) oc = 3664 + (n - C_GV); else oc = 4704 + (n - C_GR);
                colp = oc >= 0 ? A.in[15] + oc : nullptr; ld = 5728; if (n < 1024 || (n >= C_GQ && n < C_GK)) sc = RS128; WT = (h16*)(ws + WS_WIN); break; }
            case 5: colp = A.in[19] + n; ld = DM; WT = (h16*)(ws + WS_WO); break;
            case 6: colp = A.in[20] + n; ld = 512; sc = RS128; WT = (h16*)(ws + WS_WMQ); break;
            case 7: colp = A.in[23] + n; ld = DM; WT = (h16*)(ws + WS_WMO); break;
            default: colp = (n < 512) ? A.in[21] + n : A.in[22] + (n - 512); ld = 512; WT = (h16*)(ws + WS_WMKV); break;
        }
        tr_item(colp, ld, sc, K, WT, scr, k0, n0, lane);
    }
    const size_t gt = (size_t)blockIdx.x * 512 + tid, ngt = (size_t)G * 512;
    cvt_copy(A.in[0], (h16*)(ws + WS_X), (size_t)NP * DM / 8, gt, ngt);
    cvt_copy(A.in[1], (h16*)(ws + WS_X) + (size_t)NP * DM, (size_t)NS * DM / 8, gt, ngt);
    cvt_copy(A.in[8], (h16*)(ws + WS_MEMH), (size_t)512 * DM / 8, gt, ngt);
    cvt_copy(A.in[2], (h16*)(ws + WS_CK), (size_t)8192 * 256 / 8, gt, ngt);
    cvt_copy(A.in[3], (h16*)(ws + WS_CV), (size_t)8192 * 256 / 8, gt, ngt);
    cvt_copy(A.in[4], (h16*)(ws + WS_CKI), (size_t)8192 * 64 / 8, gt, ngt);
    for (size_t i = gt; i < (size_t)8192 * 256 / 8; i += ngt) { const f32x4 a = *(const f32x4*)(A.in[2] + i * 8), b = *(const f32x4*)(A.in[2] + i * 8 + 4); *(u32x2*)(ws + WS_CK8 + i * 8) = pack_fp8x8(a, b);
        const f32x4 c = *(const f32x4*)(A.in[3] + i * 8), d = *(const f32x4*)(A.in[3] + i * 8 + 4); *(u32x2*)(ws + WS_CV8 + i * 8) = pack_fp8x8(c, d); }
    cvt_copy(A.in[6], (h16*)(ws + WS_CMK), (size_t)2048 * 512 / 8, gt, ngt);
    for (size_t i = gt; i < (size_t)8 * 4 * 128 * 32; i += ngt) {
        const int n0 = (int)(i & 31) * 8, d = (int)(i >> 5) & 127, hh = (int)(i >> 12) & 3, bs = (int)(i >> 14);
        h16x8 o;
#pragma unroll
        for (int e = 0; e < 8; ++e) o[e] = (h16)A.in[7][((size_t)(bs * 256 + n0 + e) * 4 + hh) * 128 + d];
        *(u32x4*)((h16*)(ws + WS_CMVT) + ((size_t)(bs * 4 + hh) * 128 + d) * 256 + n0) = __builtin_bit_cast(u32x4, o);
    }
    if (blockIdx.x == 0 && tid < 64) ((unsigned*)(ws + WS_CTL))[tid] = 0u;
}

__device__ __forceinline__ void ln_phase(int wv, h16* X, const float* g, const float* b, float* out32, int G, const float* part, float alpha, float beta) {
    const int tid_ = opaque_tid(wv); const int lane = tid_ & 63, wave = tid_ >> 6;
    u32x4 nx[4];
    { const int r0 = blockIdx.x * 8 + wave; if (r0 < MT) {
#pragma unroll
        for (int j = 0; j < 4; ++j) nx[j] = *(const u32x4*)(X + (size_t)r0 * DM + j * 512 + lane * 8); } }
    for (int row = blockIdx.x * 8 + wave; row < MT; row += G * 8) {
        h16* xr = X + (size_t)row * DM;
        u32x4 cu[4];
#pragma unroll
        for (int j = 0; j < 4; ++j) cu[j] = nx[j];
        { const int rn = row + G * 8; if (rn < MT) {
#pragma unroll
            for (int j = 0; j < 4; ++j) nx[j] = *(const u32x4*)(X + (size_t)rn * DM + j * 512 + lane * 8); } }
        float v[32]; float s = 0.f;
#pragma unroll
        for (int j = 0; j < 4; ++j) { const h16x8 h = __builtin_bit_cast(h16x8, cu[j]);
#pragma unroll
            for (int e = 0; e < 8; ++e) v[j * 8 + e] = (float)h[e]; }
        if (part && row >= NP) {
#pragma unroll
            for (int j = 0; j < 4; ++j) { f32x4 a0 = {0.f, 0.f, 0.f, 0.f}, a1 = {0.f, 0.f, 0.f, 0.f};
#pragma unroll
                for (int ks = 0; ks < 4; ++ks) { const float* p = part + ((size_t)ks * NS + (row - NP)) * DM + j * 512 + lane * 8; a0 += *(const f32x4*)p; a1 += *(const f32x4*)(p + 4); }
#pragma unroll
                for (int e = 0; e < 4; ++e) { v[j * 8 + e] = alpha * v[j * 8 + e] + beta * a0[e]; v[j * 8 + 4 + e] = alpha * v[j * 8 + 4 + e] + beta * a1[e]; } } }
#pragma unroll
        for (int e = 0; e < 32; ++e) s += v[e];
        const float mean = wave_sum(s) * (1.f / DM); float s2 = 0.f;
#pragma unroll
        for (int e = 0; e < 32; ++e) { v[e] -= mean; s2 += v[e] * v[e]; }
        const float rstd = 1.f / sqrtf(wave_sum(s2) * (1.f / DM) + LN_EPS);
#pragma unroll
        for (int j = 0; j < 4; ++j) { const int c0 = j * 512 + lane * 8;
            const f32x4 g0 = *(const f32x4*)(g + c0), g1 = *(const f32x4*)(g + c0 + 4), b0 = *(const f32x4*)(b + c0), b1 = *(const f32x4*)(b + c0 + 4);
            f32x4 o0, o1;
#pragma unroll
            for (int e = 0; e < 4; ++e) { o0[e] = v[j * 8 + e] * rstd * g0[e] + b0[e]; o1[e] = v[j * 8 + 4 + e] * rstd * g1[e] + b1[e]; }
            if (out32) { *(f32x4*)(out32 + (size_t)row * DM + c0) = o0; *(f32x4*)(out32 + (size_t)row * DM + c0 + 4) = o1; }
            else *(u32x4*)(xr + c0) = pg8::pack8(o0, o1); }
    }
}


__device__ __forceinline__ void gla_prep(int wv, const Args& A, LAS unsigned char* lds, int G) {
    const int tid = opaque_tid(wv);
    unsigned char* ws = A.ws;
    const h16* PROJ = (const h16*)(ws + WS_HP);
    h16* QT = (h16*)(ws + WS_QT); h16* KT = (h16*)(ws + WS_KT); h16* KTT = (h16*)(ws + WS_KTT); h16* VT = (h16*)(ws + WS_VT);
    float* ER = (float*)(ws + WS_ER); float* DEC = (float*)(ws + WS_DEC); float* FF = (float*)(ws + WS_FF);
    LAS float* glr = (LAS float*)lds;
    LAS float* tot = glr + 1024;
    for (int u = blockIdx.x; u < 520 * 4; u += G) {
        const int cidx = u >> 2, h = u & 3; const size_t tok0 = (size_t)cidx * 64;
        const int k = tid & 127, tg = tid >> 7;
        h16 qv[16], kv[16], vv[32];
#pragma unroll
        for (int i = 0; i < 16; ++i) { const size_t pr = (tok0 + tg * 16 + i) * PW; qv[i] = PROJ[pr + C_GQ + h * 128 + k]; kv[i] = PROJ[pr + C_GK + h * 128 + k]; }
        { const int v = tid & 255, th = tid >> 8;
#pragma unroll
            for (int e = 0; e < 32; ++e) vv[e] = PROJ[(tok0 + th * 32 + e) * PW + C_GV + h * 256 + v]; }
        float w[16];
#pragma unroll
        for (int r = 0; r < 16; ++r) w[r] = A.in[16][r * 512 + h * 128 + k];
        const float ba = A.in[17][h * 128 + k];
        __syncthreads();
        if (tid < 128) { const int t = tid >> 1, hf = tid & 1; const h16x8 v = __builtin_bit_cast(h16x8, *(const u32x4*)(PROJ + (tok0 + t) * PW + C_GLR + hf * 8));
#pragma unroll
            for (int e = 0; e < 8; ++e) glr[t * 16 + hf * 8 + e] = (float)v[e]; }
        __syncthreads();
        float bl[16]; float run = 0.f;
#pragma unroll
        for (int i = 0; i < 16; ++i) { const int t = tg * 16 + i; float z = ba;
#pragma unroll
            for (int r = 0; r < 16; ++r) z += glr[t * 16 + r] * w[r];
            const float la = (fminf(z, 0.f) - __logf(1.f + __expf(-fabsf(z)))) * (1.f / 16.f); run += la; bl[i] = run; }
        tot[tg * 128 + k] = run;
        __syncthreads();
        const float t0 = tot[k], t1 = tot[128 + k], t2 = tot[256 + k], t3 = tot[384 + k];
        const float off = tg == 0 ? 0.f : tg == 1 ? t0 : tg == 2 ? t0 + t1 : t0 + t1 + t2;
        const float rr = t0 + t1, blast = (t0 + t1) + (t2 + t3);
        h16x8 kt8[2];
#pragma unroll
        for (int i = 0; i < 16; ++i) { const int t = tg * 16 + i; const float b = bl[i] + off;
            const float q = (float)qv[i], kk = (float)kv[i];
            const h16 qt = (h16)(q * __expf(b - rr)), ktv = (h16)(kk * __expf(rr - b));
            QT[(tok0 + t) * 512 + h * 128 + k] = qt; KT[(tok0 + t) * 512 + h * 128 + k] = ktv; kt8[i >> 3][i & 7] = (h16)(kk * __expf(blast - b)); }
        { h16* d = KTT + ((size_t)(cidx * 4 + h) * 128 + k) * 64 + tg * 16; *(u32x4*)d = __builtin_bit_cast(u32x4, kt8[0]); *(u32x4*)(d + 8) = __builtin_bit_cast(u32x4, kt8[1]); }
        if (tg == 0) { const int o = cidx * 512 + h * 128 + k; ER[o] = __expf(rr); DEC[o] = __expf(blast); FF[o] = __expf(blast - rr); }
        { const int v = tid & 255, th = tid >> 8;
#pragma unroll
            for (int c4 = 0; c4 < 4; ++c4) { h16x8 o;
#pragma unroll
                for (int e = 0; e < 8; ++e) o[e] = vv[c4 * 8 + e];
                *(u32x4*)(VT + ((size_t)(cidx * 4 + h) * 256 + v) * 64 + th * 32 + c4 * 8) = __builtin_bit_cast(u32x4, o); } }
    }
}

__device__ __forceinline__ u32x4 ldg16(const void* base, unsigned off) { return *(const u32x4*)((const char*)base + off); }
__device__ __forceinline__ void gla_chain(int wv, const Args& A, LAS unsigned char* lds, int cidx0, int nsteps, int h, int sl, const float* S0, float* Sout) {
    const int tid = opaque_tid(wv), lane = tid & 63, w = __builtin_amdgcn_readfirstlane(tid >> 6), fr = lane & 15, fq = lane >> 4;
    unsigned char* ws = A.ws;
    constexpr int BUFB = 54272;
    LAS unsigned char* STs = lds + 2 * BUFB;
    LAS unsigned char* As = lds + 2 * BUFB + 17408;
    const unsigned g_q = (unsigned)((tid >> 4) * 512 + (tid & 15) * 8) * 2u;
    const unsigned l_q = (unsigned)((tid >> 4) * 136 + (tid & 15) * 8) * 2u;
    const unsigned g_t = (unsigned)((tid >> 3) * 64 + (tid & 7) * 8) * 2u;
    const unsigned l_t = (unsigned)((tid >> 3) * 72 + (tid & 7) * 8) * 2u;
    const unsigned g_v = (unsigned)(fr * 64 + fq * 8) * 2u;
    const unsigned f136 = (unsigned)(fr * 136 + fq * 8) * 2u;
    const unsigned f72 = (unsigned)(fr * 72 + fq * 8) * 2u;
    const unsigned w136 = (unsigned)(fr * 136 + fq * 4) * 2u;
    const unsigned w72 = (unsigned)(fr * 72 + fq * 4) * 2u;
    const unsigned g_go = (unsigned)(fr * DM + fq * 4) * 2u;
    f32x4 Sacc[4];
#pragma unroll
    for (int vbl = 0; vbl < 4; ++vbl)
#pragma unroll
        for (int r = 0; r < 4; ++r) Sacc[vbl][r] = S0 ? *(const float*)((const char*)(S0 + (w * 16 + r) * 256 + sl * 64 + vbl * 16) + (unsigned)(fq * 4 * 256 + fr) * 4u) : 0.f;
    u32x4 rq[2], rk[2], rt[2]; float rs = 0.f; h16x8 vt[4][2], vo[2][2];
#define GLA_ISSUE(CIDX) do { const int c_ = (CIDX); const size_t t_ = (size_t)c_ * 64; \
        const char* uQ = (const char*)(ws + WS_QT) + (t_ * 512 + h * 128) * 2; const char* uK = (const char*)(ws + WS_KT) + (t_ * 512 + h * 128) * 2; \
        const char* uT = (const char*)(ws + WS_KTT) + (size_t)(c_ * 4 + h) * 128 * 64 * 2; const char* uV = (const char*)(ws + WS_VT) + ((size_t)(c_ * 4 + h) * 256 + sl * 64) * 64 * 2; \
        _Pragma("unroll") for (int i = 0; i < 2; ++i) { rq[i] = ldg16(uQ + i * 32 * 512 * 2, g_q); rk[i] = ldg16(uK + i * 32 * 512 * 2, g_q); rt[i] = ldg16(uT + i * 64 * 64 * 2, g_t); } \
        if (tid < 256) rs = ((const float*)(ws + (tid < 128 ? WS_ER : WS_DEC)))[c_ * 512 + h * 128 + (tid & 127)]; \
        _Pragma("unroll") for (int vbl = 0; vbl < 4; ++vbl) _Pragma("unroll") for (int ks = 0; ks < 2; ++ks) vt[vbl][ks] = __builtin_bit_cast(h16x8, ldg16(uV + (vbl * 16 * 64 + ks * 32) * 2, g_v)); \
        _Pragma("unroll") for (int j = 0; j < 2; ++j) _Pragma("unroll") for (int ks = 0; ks < 2; ++ks) vo[j][ks] = __builtin_bit_cast(h16x8, ldg16(uV + (((w & 1) * 2 + j) * 16 * 64 + ks * 32) * 2, g_v)); } while (0)
    GLA_ISSUE(cidx0);
    for (int step = 0; step < nsteps; ++step) {
        const int cidx = cidx0 + step; const size_t tok0 = (size_t)cidx * 64;
        LAS unsigned char* buf = lds + (step & 1) * BUFB;
        LAS unsigned char* QTs = buf; LAS unsigned char* KTs = buf + 17408; LAS unsigned char* KTTs = buf + 34816; LAS float* scal = (LAS float*)(buf + 53248);
#pragma unroll
        for (int i = 0; i < 2; ++i) { *(LAS u32x4*)(QTs + l_q + i * 32 * 136 * 2) = rq[i]; *(LAS u32x4*)(KTs + l_q + i * 32 * 136 * 2) = rk[i]; *(LAS u32x4*)(KTTs + l_t + i * 64 * 72 * 2) = rt[i]; }
        if (tid < 256) scal[tid] = rs;
        h16x8 vc[4][2];
#pragma unroll
        for (int vbl = 0; vbl < 4; ++vbl)
#pragma unroll
            for (int ks = 0; ks < 2; ++ks) vc[vbl][ks] = vt[vbl][ks];
        h16x8 voc[2][2];
#pragma unroll
        for (int j = 0; j < 2; ++j) { voc[j][0] = vo[j][0]; voc[j][1] = vo[j][1]; }
        if (step + 1 < nsteps) GLA_ISSUE(cidx + 1);
        __syncthreads();
#pragma unroll
        for (int vbl = 0; vbl < 4; ++vbl) { h16x4 s4;
#pragma unroll
            for (int r = 0; r < 4; ++r) s4[r] = (h16)(Sacc[vbl][r] * scal[w * 16 + fq * 4 + r]);
            *(LAS u32x2*)(STs + w136 + (vbl * 16 * 136 + w * 16) * 2) = __builtin_bit_cast(u32x2, s4); }
#pragma unroll
        for (int tt = 0; tt < 2; ++tt) { const int t = 2 * w + tt, ib = t >> 2, jb = t & 3; f32x4 a = {0.f, 0.f, 0.f, 0.f};
            if (jb <= ib) {
#pragma unroll
                for (int ks = 0; ks < 4; ++ks) { const h16x8 kf = *(const LAS h16x8*)(KTs + f136 + (jb * 16 * 136 + ks * 32) * 2), qf = *(const LAS h16x8*)(QTs + f136 + (ib * 16 * 136 + ks * 32) * 2);
                    a = __builtin_amdgcn_mfma_f32_16x16x32_f16(kf, qf, a, 0, 0, 0); }
#pragma unroll
                for (int r = 0; r < 4; ++r) if (jb * 16 + fq * 4 + r > ib * 16 + fr) a[r] = 0.f;
            }
            h16x4 a4; a4[0] = (h16)a[0]; a4[1] = (h16)a[1]; a4[2] = (h16)a[2]; a4[3] = (h16)a[3];
            *(LAS u32x2*)(As + w72 + (ib * 16 * 72 + jb * 16) * 2) = __builtin_bit_cast(u32x2, a4); }
        __syncthreads();
        { const int ib = w >> 1;
#pragma unroll
            for (int j = 0; j < 2; ++j) { const int vbl = (w & 1) * 2 + j; f32x4 o = {0.f, 0.f, 0.f, 0.f};
#pragma unroll
                for (int ks = 0; ks < 4; ++ks) { const h16x8 sf = *(const LAS h16x8*)(STs + f136 + (vbl * 16 * 136 + ks * 32) * 2), qf = *(const LAS h16x8*)(QTs + f136 + (ib * 16 * 136 + ks * 32) * 2);
                    o = __builtin_amdgcn_mfma_f32_16x16x32_f16(sf, qf, o, 0, 0, 0); }
#pragma unroll
                for (int ks = 0; ks < 2; ++ks) { const h16x8 af = *(const LAS h16x8*)(As + f72 + (ib * 16 * 72 + ks * 32) * 2);
                    o = __builtin_amdgcn_mfma_f32_16x16x32_f16(voc[j][ks], af, o, 0, 0, 0); }
                h16x4 o4; o4[0] = (h16)o[0]; o4[1] = (h16)o[1]; o4[2] = (h16)o[2]; o4[3] = (h16)o[3];
                *(u32x2*)((char*)(ws + WS_MIX) + ((tok0 + ib * 16) * DM + 1024 + h * 256 + sl * 64 + vbl * 16) * 2 + g_go) = __builtin_bit_cast(u32x2, o4); } }
#pragma unroll
        for (int vbl = 0; vbl < 4; ++vbl) {
#pragma unroll
            for (int r = 0; r < 4; ++r) Sacc[vbl][r] *= scal[128 + w * 16 + fq * 4 + r];
#pragma unroll
            for (int ks = 0; ks < 2; ++ks) { const h16x8 kf = *(const LAS h16x8*)(KTTs + f72 + (w * 16 * 72 + ks * 32) * 2);
                Sacc[vbl] = __builtin_amdgcn_mfma_f32_16x16x32_f16(kf, vc[vbl][ks], Sacc[vbl], 0, 0, 0); } }
    }
#undef GLA_ISSUE
#pragma unroll
    for (int vbl = 0; vbl < 4; ++vbl)
#pragma unroll
        for (int r = 0; r < 4; ++r) *(float*)((char*)(Sout + (w * 16 + r) * 256 + sl * 64 + vbl * 16) + (unsigned)(fq * 4 * 256 + fr) * 4u) = Sacc[vbl][r];
    __syncthreads();
}
__device__ __forceinline__ void gla_out_phase(int wv, const Args& A, int G) {
    const int tid = opaque_tid(wv), lane = tid & 63, w = tid >> 6;
    unsigned char* ws = A.ws;
    const h16* PROJ = (const h16*)(ws + WS_HP); h16* MIX = (h16*)(ws + WS_MIX);
    for (int row0 = (blockIdx.x * 8 + w) * 2; row0 < MT * 4; row0 += G * 16) {
        h16x4 o4[2], gr[2]; f32x4 gn[2];
#pragma unroll
        for (int u = 0; u < 2; ++u) { const int row = row0 + u; const size_t tok = (size_t)(row >> 2); const int h = row & 3;
            o4[u] = __builtin_bit_cast(h16x4, *(const u32x2*)(MIX + tok * DM + 1024 + h * 256 + lane * 4));
            gr[u] = __builtin_bit_cast(h16x4, *(const u32x2*)(PROJ + tok * PW + C_GR + h * 256 + lane * 4));
            gn[u] = *(const f32x4*)(A.in[18] + h * 256 + lane * 4); }
#pragma unroll
        for (int u = 0; u < 2; ++u) { const int row = row0 + u; const size_t tok = (size_t)(row >> 2); const int h = row & 3;
            float x[4]; float s = 0.f;
#pragma unroll
            for (int r = 0; r < 4; ++r) { x[r] = (float)o4[u][r]; s += x[r]; }
            const float mean = wave_sum(s) * (1.f / 256.f); float q = 0.f;
#pragma unroll
            for (int r = 0; r < 4; ++r) { x[r] -= mean; q += x[r] * x[r]; }
            const float rstd = 1.f / sqrtf(wave_sum(q) * (1.f / 256.f) + LN_EPS); h16x4 y;
#pragma unroll
            for (int r = 0; r < 4; ++r) { const float g = (float)gr[u][r]; y[r] = (h16)(x[r] * rstd * gn[u][r] * (g * __builtin_amdgcn_rcpf(1.f + __expf(-g)))); }
            *(u32x2*)(MIX + tok * DM + 1024 + h * 256 + lane * 4) = __builtin_bit_cast(u32x2, y); }
    }
}

constexpr int CAP = 1216;
__device__ __forceinline__ const h16* key_row(const unsigned char* ws, int s, int j, int ccol, size_t cache_off, int cw) {
    const h16* tab = (ccol == C_KI) ? (const h16*)(ws + WS_KIC) : (const h16*)(ws + WS_KVC) + (ccol == C_V ? 256 : 0);
    const int stride = (ccol == C_KI) ? 64 : 512;
    if (s < 2) return tab + ((size_t)s * SEQ + j) * stride;
    const int bs = s - 2;
    if (j < PAST) return (const h16*)(ws + cache_off) + ((size_t)bs * PAST + j) * cw;
    return tab + ((size_t)NP + bs * 64 + (j - PAST)) * stride;
}
__device__ __forceinline__ unsigned f2ord(float f) { const unsigned u = __builtin_bit_cast(unsigned, f); return u ^ ((u >> 31) ? 0xFFFFFFFFu : 0x80000000u); }
__device__ __forceinline__ float ord2f(unsigned x) { const unsigned u = (x >> 31) ? (x ^ 0x80000000u) : ~x; return __builtin_bit_cast(float, u); }
template <bool FINAL>
__device__ __forceinline__ void dsa_prune(LAS unsigned* cs, LAS unsigned short* ci, LAS unsigned* cnt, LAS float* thr, int q, int lane) {
    const int n = __builtin_amdgcn_readfirstlane((int)cnt[q]);
    if (n <= 256) return;
    LAS unsigned* c = cs + q * CAP; LAS unsigned short* ix = ci + q * CAP;
    constexpr int NE = CAP / 64;
    unsigned x[NE];
#pragma unroll
    for (int i = 0; i < NE; ++i) { const int e = i * 64 + lane; x[i] = e < n ? c[e] : 0u; }
    unsigned prefix = 0u; int kp = n;
    for (int bit = 31; bit >= 0; --bit) { const unsigned trial = prefix | (1u << bit); int k = 0;
#pragma unroll
        for (int i = 0; i < NE; ++i) k += __popcll(__ballot(x[i] >= trial));
        if (k >= 256) { prefix = trial; kp = k; }
        if (kp == 256 || (!FINAL && bit <= 16 && kp <= 320)) break; }
    int base = 0;
#pragma unroll
    for (int i = 0; i < NE; ++i) { const int e = i * 64 + lane; const unsigned short id = e < n ? ix[e] : (unsigned short)0;
        const bool keep = x[i] >= prefix; const unsigned long long mask = __ballot(keep);
        const int pos = base + (int)__builtin_amdgcn_mbcnt_hi((unsigned)(mask >> 32), __builtin_amdgcn_mbcnt_lo((unsigned)mask, 0u));
        LDS_WAIT();
        if (keep) { c[pos] = x[i]; ix[pos] = id; }
        base += __popcll(mask); }
    if (lane == 0) { cnt[q] = (unsigned)base; thr[q] = ord2f(prefix); }
}
__device__ __forceinline__ int rel_bucket(int rel) {
    const int n = rel < 0 ? -rel : rel;
    const int b = n < 8 ? n : 8 + (n >= 12) + (n >= 16) + (n >= 23) + (n >= 32) + (n >= 46) + (n >= 64) + (n >= 91);
    return b + (rel > 0 ? 16 : 0);
}
__device__ __forceinline__ void dsa_unit(int wv, const Args& A, LAS unsigned char* lds, int s, int qt) {
    const int tid = opaque_tid(wv), lane = tid & 63, w = __builtin_amdgcn_readfirstlane(tid >> 6), fr = lane & 15, fq = lane >> 4;
    const unsigned char* ws = A.ws;
    const h16* PROJ = (const h16*)(ws + WS_HP); h16* MIX = (h16*)(A.ws + WS_MIX);
    const bool prompt = s < 2; const int bs = s - 2;
    const int L = prompt ? 64 * ((qt >> 2) + 1) : (PAST + 64);
    const size_t qrow0 = prompt ? (size_t)s * SEQ + qt * 16 : (size_t)NP + bs * 64 + qt * 16;
    const int qpos0 = prompt ? qt * 16 : PAST + qt * 16;
    LAS unsigned* cs = (LAS unsigned*)lds;
    LAS unsigned short* ci = (LAS unsigned short*)(lds + 77824);
    LAS unsigned* cnt = (LAS unsigned*)(lds + 116736);
    LAS float* thr = (LAS float*)(lds + 116800);
    LAS float* relb = (LAS float*)(lds + 116864);
    LAS h16* Pw = (LAS h16*)(lds + 117888 + w * 4096);
    LAS float* wql = (LAS float*)(lds + 152704);
    if (tid < 16) { cnt[tid] = 0u; thr[tid] = -INFINITY; }
    if (tid < 256) relb[tid] = A.in[9][tid];
    LAS u32x4* Ql = (LAS u32x4*)(lds + 117888);
    const h16* qp = PROJ + (qrow0 + fr) * PW;
    float wq[16];
    { const h16x8 w0 = __builtin_bit_cast(h16x8, *(const u32x4*)(qp + C_WI)), w1 = __builtin_bit_cast(h16x8, *(const u32x4*)(qp + C_WI + 8));
#pragma unroll
        for (int e = 0; e < 8; ++e) { wq[e] = (float)w0[e]; wq[8 + e] = (float)w1[e]; } }
#pragma unroll
    for (int i = 0; i < 4; ++i) { const int c = tid + i * 512; const int hh = c >> 7, ks = (c >> 6) & 1, ln = c & 63;
        Ql[c] = *(const u32x4*)(PROJ + (qrow0 + (ln & 15)) * PW + C_QI + hh * 64 + ks * 32 + (ln >> 4) * 8); }
    if (w == 2 && fq == 0) {
#pragma unroll
        for (int hh = 0; hh < 16; ++hh) wql[hh * 16 + fr] = wq[hh]; }
    if (w < 2) { float lin[8];
#pragma unroll
        for (int e = 0; e < 8; ++e) lin[e] = 0.f;
#pragma unroll
        for (int hh = 0; hh < 16; ++hh) { const h16x8 qv = __builtin_bit_cast(h16x8, *(const u32x4*)(qp + C_QI + hh * 64 + w * 32 + fq * 8));
#pragma unroll
            for (int e = 0; e < 8; ++e) lin[e] += wq[hh] * (float)qv[e]; }
        h16x8 lh;
#pragma unroll
        for (int e = 0; e < 8; ++e) lh[e] = (h16)lin[e];
        Ql[(32 + w) * 64 + lane] = __builtin_bit_cast(u32x4, lh); }
    __syncthreads();
    float th = -INFINITY;
    const int ntiles = L >> 4;
    h16x8 nK[4][2];
#define DSA_LOADK(KT) do { const int kt_ = (KT); if (kt_ < ntiles) { _Pragma("unroll") for (int t_ = 0; t_ < 4; ++t_) { const h16* p_ = key_row(ws, s, (kt_ + t_) * 16 + fr, C_KI, WS_CKI, 64); \
        nK[t_][0] = __builtin_bit_cast(h16x8, *(const u32x4*)(p_ + fq * 8)); nK[t_][1] = __builtin_bit_cast(h16x8, *(const u32x4*)(p_ + 32 + fq * 8)); } } } while (0)
#pragma unroll
    for (int t = 0; t < 4; ++t) { nK[t][0] = (h16x8){0, 0, 0, 0, 0, 0, 0, 0}; nK[t][1] = (h16x8){0, 0, 0, 0, 0, 0, 0, 0}; }
    DSA_LOADK(4 * w);
    for (int kt0 = 0; kt0 < ntiles; kt0 += 32) {
        const int kt = kt0 + 4 * w;
        h16x8 kc[4][2];
#pragma unroll
        for (int t = 0; t < 4; ++t) { kc[t][0] = nK[t][0]; kc[t][1] = nK[t][1]; }
        DSA_LOADK(kt + 32);
        if (kt < ntiles) {
            f32x4 sc[4];
#pragma unroll
            for (int t = 0; t < 4; ++t) sc[t] = (f32x4){0.f, 0.f, 0.f, 0.f};
#pragma unroll 2
            for (int hh = 0; hh < 16; ++hh) {
                const h16x8 q0 = __builtin_bit_cast(h16x8, Ql[(hh * 2) * 64 + lane]), q1 = __builtin_bit_cast(h16x8, Ql[(hh * 2 + 1) * 64 + lane]);
                const float wh = wql[hh * 16 + fr];
                f32x4 a[4];
#pragma unroll
                for (int t = 0; t < 4; ++t) a[t] = __builtin_amdgcn_mfma_f32_16x16x32_f16(kc[t][0], q0, (f32x4){0.f, 0.f, 0.f, 0.f}, 0, 0, 0);
#pragma unroll
                for (int t = 0; t < 4; ++t) a[t] = __builtin_amdgcn_mfma_f32_16x16x32_f16(kc[t][1], q1, a[t], 0, 0, 0);
#pragma unroll
                for (int t = 0; t < 4; ++t)
#pragma unroll
                    for (int r = 0; r < 4; ++r) sc[t][r] += wh * fabsf(a[t][r]);
            }
            { const h16x8 q0 = __builtin_bit_cast(h16x8, Ql[32 * 64 + lane]), q1 = __builtin_bit_cast(h16x8, Ql[33 * 64 + lane]);
#pragma unroll
                for (int t = 0; t < 4; ++t) { sc[t] = __builtin_amdgcn_mfma_f32_16x16x32_f16(kc[t][0], q0, sc[t], 0, 0, 0); sc[t] = __builtin_amdgcn_mfma_f32_16x16x32_f16(kc[t][1], q1, sc[t], 0, 0, 0); } }
            int c = 0;
#pragma unroll
            for (int t = 0; t < 4; ++t)
#pragma unroll
                for (int r = 0; r < 4; ++r) c += (sc[t][r] > th) ? 1 : 0;
            if (c) { unsigned pos = __hip_atomic_fetch_add((unsigned*)(cnt + fr), (unsigned)c, __ATOMIC_RELAXED, __HIP_MEMORY_SCOPE_WORKGROUP);
#pragma unroll
                for (int t = 0; t < 4; ++t)
#pragma unroll
                    for (int r = 0; r < 4; ++r) if (sc[t][r] > th) { if (pos < (unsigned)CAP) { cs[fr * CAP + pos] = f2ord(sc[t][r]); ci[fr * CAP + pos] = (unsigned short)((kt + t) * 16 + fq * 4 + r); } ++pos; } }
        }
        __syncthreads();
        const bool need = __ballot(cnt[fr] > (unsigned)(CAP - 512)) != 0ull;
        if (need) { dsa_prune<false>(cs, ci, cnt, thr, 2 * w, lane); dsa_prune<false>(cs, ci, cnt, thr, 2 * w + 1, lane); }
        __syncthreads();
        if (need) th = thr[fr];
    }
#undef DSA_LOADK
    if (lane < 2) { if (cnt[2 * w + lane] > (unsigned)CAP) cnt[2 * w + lane] = (unsigned)CAP; }
    dsa_prune<true>(cs, ci, cnt, thr, 2 * w, lane); dsa_prune<true>(cs, ci, cnt, thr, 2 * w + 1, lane);
    for (int qi2 = 0; qi2 < 2; ++qi2) {
        const int qq = 2 * w + qi2; int n = __builtin_amdgcn_readfirstlane((int)cnt[qq]); n = n > 256 ? 256 : n;
        const size_t qrow = qrow0 + qq; const int qpos = qpos0 + qq;
        LAS const unsigned short* lst = ci + qq * CAP;
        long qf[8];
#pragma unroll
        for (int kk = 0; kk < 8; ++kk) { qf[kk] = 0;
            if (fr < 8 && (fr >> 2) == (kk >> 2)) { const h16x8 q = __builtin_bit_cast(h16x8, *(const u32x4*)(PROJ + qrow * PW + C_Q + fr * 128 + ((kk >> 1) & 1) * 64 + fq * 16 + (kk & 1) * 8));
                f32x4 a, bq;
#pragma unroll
                for (int e = 0; e < 4; ++e) { a[e] = 16.f * (float)q[e]; bq[e] = 16.f * (float)q[4 + e]; }
                qf[kk] = __builtin_bit_cast(long, pack_fp8x8(a, bq)); } }
        const int nt = n >> 4;
        long kf[8];
#define DSA_LOADT(DST, T) do { const int t_ = (T) < nt ? (T) : nt - 1; const int j_ = lst[t_ * 16 + fr]; \
        const unsigned char* kp_ = (s < 2) ? ws + WS_KC8 + ((size_t)s * SEQ + j_) * 256 : (j_ < PAST ? ws + WS_CK8 + ((size_t)(s - 2) * PAST + j_) * 256 : ws + WS_KC8 + ((size_t)NP + (s - 2) * 64 + (j_ - PAST)) * 256); \
        _Pragma("unroll") for (int k2 = 0; k2 < 4; ++k2) { const u32x4 w_ = *(const u32x4*)(kp_ + k2 * 64 + fq * 16); u32x2 lo_, hi_; lo_[0] = w_[0]; lo_[1] = w_[1]; hi_[0] = w_[2]; hi_[1] = w_[3]; \
            DST[2 * k2] = __builtin_bit_cast(long, lo_); DST[2 * k2 + 1] = __builtin_bit_cast(long, hi_); } } while (0)
        DSA_LOADT(kf, 0);
        for (int kt = 0; kt < nt; ++kt) {
            long k1[8];
            DSA_LOADT(k1, kt + 1);
            f32x4 a = {0.f, 0.f, 0.f, 0.f};
#pragma unroll
            for (int kk = 0; kk < 8; ++kk) a = __builtin_amdgcn_mfma_f32_16x16x32_fp8_fp8(kf[kk], qf[kk], a, 0, 0, 0);
            if (fr < 8) {
#pragma unroll
                for (int r = 0; r < 4; ++r) { const int e2 = kt * 16 + fq * 4 + r; const int key2 = lst[e2];
                    Pw[e2 * 8 + fr] = (h16)(a[r] * 0.0625f + relb[rel_bucket(key2 - qpos) * 8 + fr]); } }
#pragma unroll
            for (int kk = 0; kk < 8; ++kk) kf[kk] = k1[kk];
        }
#undef DSA_LOADT
        { float v[4][8]; float m[8];
#pragma unroll
            for (int hh = 0; hh < 8; ++hh) m[hh] = -INFINITY;
#pragma unroll
            for (int i = 0; i < 4; ++i) { const int e = lane * 4 + i; const h16x8 hv = e < n ? *(const LAS h16x8*)(Pw + e * 8) : (h16x8){0, 0, 0, 0, 0, 0, 0, 0};
#pragma unroll
                for (int j = 0; j < 8; ++j) { v[i][j] = e < n ? (float)hv[j] : -INFINITY; m[j] = fmaxf(m[j], v[i][j]); } }
            float sm[8];
#pragma unroll
            for (int hh = 0; hh < 8; ++hh) { m[hh] = wave_max(m[hh]); sm[hh] = 0.f; }
#pragma unroll
            for (int i = 0; i < 4; ++i)
#pragma unroll
                for (int j = 0; j < 8; ++j) { const float p = __expf(v[i][j] - m[j]); v[i][j] = p; sm[j] += p; }
#pragma unroll
            for (int hh = 0; hh < 8; ++hh) sm[hh] = 1.f / wave_sum(sm[hh]);
#pragma unroll
            for (int i = 0; i < 4; ++i) { const int e = lane * 4 + i;
                if (e < n) { h16x8 o;
#pragma unroll
                    for (int j = 0; j < 8; ++j) o[j] = (h16)(v[i][j] * sm[j]);
                    *(LAS h16x8*)(Pw + e * 8) = o; } } }
        { const int ksub = lane >> 4, sl16 = lane & 15, g = sl16 >> 3;
            float acc[4][16];
#pragma unroll
            for (int hh = 0; hh < 4; ++hh)
#pragma unroll
                for (int d = 0; d < 16; ++d) acc[hh][d] = 0.f;
            for (int eb = 0; eb < n; eb += 64) {
                h16x2 a2[4][8];
#pragma unroll
                for (int hh = 0; hh < 4; ++hh)
#pragma unroll
                    for (int d2 = 0; d2 < 8; ++d2) a2[hh][d2] = (h16x2){0, 0};
#pragma unroll
                for (int e0 = 0; e0 < 64; e0 += 4) { const int e = eb + e0 + ksub; const int j_ = lst[e];
                    const unsigned char* vp = (s < 2) ? ws + WS_VC8 + ((size_t)s * SEQ + j_) * 256 : (j_ < PAST ? ws + WS_CV8 + ((size_t)(s - 2) * PAST + j_) * 256 : ws + WS_VC8 + ((size_t)NP + (s - 2) * 64 + (j_ - PAST)) * 256);
                    const u32x4 wv8 = *(const u32x4*)(vp + sl16 * 16);
                    const h16x4 ph = *(const LAS h16x4*)(Pw + e * 8 + g * 4);
                    h16x2 v2[8];
#pragma unroll
                    for (int d2 = 0; d2 < 8; ++d2) { const f32x2 f2 = (d2 & 1) ? __builtin_amdgcn_cvt_pk_f32_fp8((int)wv8[d2 >> 1], true) : __builtin_amdgcn_cvt_pk_f32_fp8((int)wv8[d2 >> 1], false);
                        v2[d2] = (h16x2){(h16)f2[0], (h16)f2[1]}; }
#pragma unroll
                    for (int hh = 0; hh < 4; ++hh) { const h16x2 pp = {ph[hh], ph[hh]};
#pragma unroll
                        for (int d2 = 0; d2 < 8; ++d2) a2[hh][d2] = __builtin_elementwise_fma(pp, v2[d2], a2[hh][d2]); } }
#pragma unroll
                for (int hh = 0; hh < 4; ++hh)
#pragma unroll
                    for (int d2 = 0; d2 < 8; ++d2) { acc[hh][2 * d2] += (float)a2[hh][d2][0]; acc[hh][2 * d2 + 1] += (float)a2[hh][d2][1]; }
            }
#pragma unroll
            for (int hh = 0; hh < 4; ++hh) { h16x8 o8a, o8b;
#pragma unroll
                for (int d = 0; d < 16; ++d) { float t = acc[hh][d] + __shfl_xor(acc[hh][d], 16); t += __shfl_xor(t, 32); if (d < 8) o8a[d] = (h16)t; else o8b[d - 8] = (h16)t; }
                if (ksub == 0) { h16* op = MIX + qrow * DM + (g * 4 + hh) * 128 + (sl16 & 7) * 16; *(u32x4*)op = __builtin_bit_cast(u32x4, o8a); *(u32x4*)(op + 8) = __builtin_bit_cast(u32x4, o8b); } } }
    }
    __syncthreads();
}

__device__ __forceinline__ void mixer_phase(int wv, const Args& A, LAS unsigned char* lds) {
    LAS int* itemw = (LAS int*)(lds + LDS_BYTES - 64);
    unsigned* ctr = (unsigned*)(A.ws + WS_CTL);
    constexpr int N_GP = 32, N_DP = 2048, N_DS = 32, N_GS = 128, NIT = N_GP + N_DP + N_DS + N_GS;
    for (;;) {
        __syncthreads();
        if (opaque_tid(wv) == 0) *itemw = (int)atomicAdd(ctr, 1u);
        __syncthreads();
        int it = *itemw;
        if (it >= NIT) break;
        if (it < N_GP) { const int b = it >> 4, h = (it >> 2) & 3, sl = it & 3; gla_chain(wv, A, lds, b * 256, 256, h, sl, nullptr, A.out + O_SP + (size_t)(b * 4 + h) * 32768); continue; }
        it -= N_GP;
        if (it < N_DP) { dsa_unit(wv, A, lds, it & 1, 1023 - (it >> 1)); continue; }
        it -= N_DP;
        if (it < N_DS) { dsa_unit(wv, A, lds, 2 + (it >> 2), it & 3); continue; }
        it -= N_DS;
        { const int bs = it >> 4, h = (it >> 2) & 3, sl = it & 3; gla_chain(wv, A, lds, 512 + bs, 1, h, sl, A.in[5] + (size_t)(bs * 4 + h) * 32768, A.out + O_SS + (size_t)(bs * 4 + h) * 32768); }
    }
}

__device__ __forceinline__ void mem_attn_phase(int wv, const Args& A, LAS unsigned char* lds, int G) {
    const int tid = opaque_tid(wv), lane = tid & 63, w = tid >> 6, fr = lane & 15, fq = lane >> 4;
    unsigned char* ws = A.ws;
    const h16* MQ = (const h16*)(ws + WS_MQ); h16* MO = (h16*)(ws + WS_MO);
    LAS h16* Pw = (LAS h16*)(lds + w * 8448);
    for (int wu = blockIdx.x * 8 + w; wu < (MT / 16) * 4; wu += G * 8) {
        const int blk = wu >> 3; const int h = blk & 3, tile = (blk >> 2) * 8 + (wu & 7); const size_t row0 = (size_t)tile * 16;
        const h16* Kb; const h16* VTb;
        if (row0 < NP) { const int b = (int)(row0 >> 14); Kb = (const h16*)(ws + WS_MK16) + (size_t)b * 256 * 512; VTb = (const h16*)(ws + WS_MVT) + (size_t)(b * 4 + h) * 32768; }
        else { const int bs = (int)((row0 - NP) >> 6); Kb = (const h16*)(ws + WS_CMK) + (size_t)bs * 256 * 512; VTb = (const h16*)(ws + WS_CMVT) + (size_t)(bs * 4 + h) * 32768; }
        h16x8 qf[4];
#pragma unroll
        for (int ks = 0; ks < 4; ++ks) qf[ks] = __builtin_bit_cast(h16x8, *(const u32x4*)(MQ + (row0 + fr) * 512 + h * 128 + ks * 32 + fq * 8));
        f32x4 lg[16]; float m = -INFINITY;
#pragma unroll
        for (int kt = 0; kt < 16; ++kt) { f32x4 a = {0.f, 0.f, 0.f, 0.f};
#pragma unroll
            for (int ks = 0; ks < 4; ++ks) { const h16x8 kf = __builtin_bit_cast(h16x8, *(const u32x4*)(Kb + (size_t)(kt * 16 + fr) * 512 + h * 128 + ks * 32 + fq * 8)); a = __builtin_amdgcn_mfma_f32_16x16x32_f16(kf, qf[ks], a, 0, 0, 0); }
            lg[kt] = a; m = fmaxf(m, fmaxf(fmaxf(a[0], a[1]), fmaxf(a[2], a[3]))); }
        m = fmaxf(m, __shfl_xor(m, 16)); m = fmaxf(m, __shfl_xor(m, 32));
        float sm = 0.f;
#pragma unroll
        for (int kt = 0; kt < 16; ++kt) { h16x4 p4;
#pragma unroll
            for (int r = 0; r < 4; ++r) { const float p = __expf(lg[kt][r] - m); sm += p; p4[r] = (h16)p; }
            *(LAS u32x2*)(Pw + fr * 264 + kt * 16 + fq * 4) = __builtin_bit_cast(u32x2, p4); }
        sm += __shfl_xor(sm, 16); sm += __shfl_xor(sm, 32);
        const float inv = 1.f / sm;
#pragma unroll
        for (int db = 0; db < 8; ++db) { f32x4 o = {0.f, 0.f, 0.f, 0.f};
#pragma unroll
            for (int ks = 0; ks < 8; ++ks) { const h16x8 vf = __builtin_bit_cast(h16x8, *(const u32x4*)(VTb + (size_t)(db * 16 + fr) * 256 + ks * 32 + fq * 8));
                const h16x8 pf = *(const LAS h16x8*)(Pw + fr * 264 + ks * 32 + fq * 8); o = __builtin_amdgcn_mfma_f32_16x16x32_f16(vf, pf, o, 0, 0, 0); }
            h16x4 o4; o4[0] = (h16)(o[0] * inv); o4[1] = (h16)(o[1] * inv); o4[2] = (h16)(o[2] * inv); o4[3] = (h16)(o[3] * inv);
            *(u32x2*)(MO + (row0 + fr) * 512 + h * 128 + db * 16 + fq * 4) = __builtin_bit_cast(u32x2, o4); }
    }
}

#define XB_TMO      128
#define XB_XCNT(j)  (256  + 64 * (j))
#define XB_XSUB(j)  (1280 + 64 * (j))
#define XB_XGEN(j)  (2304 + 64 * (j))
#define XB_TOP      3328
#define XB_TOPGEN   3392
#define XCD_BAR_WORDS 3456
#define XB_SPIN_CAP (1u << 18)

__device__ __forceinline__ unsigned xb_ld(unsigned* p)              { return __hip_atomic_load(p, __ATOMIC_RELAXED, __HIP_MEMORY_SCOPE_AGENT); }
__device__ __forceinline__ unsigned xb_add(unsigned* p, unsigned v) { return __hip_atomic_fetch_add(p, v, __ATOMIC_RELAXED, __HIP_MEMORY_SCOPE_AGENT); }
__device__ __forceinline__ unsigned xb_xcc_id() { return (unsigned)__builtin_amdgcn_s_getreg((3 << 11) | 20) & 0xFu; }
#define XB_SPIN(cond, bar) do { unsigned _sp = 0; while (cond) { __builtin_amdgcn_s_sleep(1); \
    if ((++_sp & 255u) == 0u) { if (xb_ld(&(bar)[XB_TMO])) break; if (_sp > XB_SPIN_CAP) { atomicAdd(&(bar)[XB_TMO], 1u); break; } } } } while (0)

struct XcdBarrier {
    unsigned* bar; unsigned x;
    volatile LAS unsigned* st;
};

__device__ __forceinline__ XcdBarrier xcd_barrier_post(unsigned* bar, volatile LAS unsigned* st) {
    XcdBarrier b; b.bar = bar; b.x = xb_xcc_id(); b.st = st;
    if (threadIdx.x == 0) (void)xb_add(&bar[XB_XCNT(b.x)], 1u);
    return b;
}
__device__ __forceinline__ void xcd_barrier_complete(unsigned* bar, unsigned x, unsigned& nloc, unsigned& nx) {
    const unsigned G = gridDim.x * gridDim.y * gridDim.z;
    unsigned sum, cnt, mine, sp = 0u;
    for (;;) {
        sum = 0u; cnt = 0u; mine = 0u;
#pragma unroll
        for (unsigned j = 0; j < 16; ++j) { const unsigned c = xb_ld(&bar[XB_XCNT(j)]); sum += c; cnt += (c > 0u) ? 1u : 0u; mine = (j == x) ? c : mine; }
        if (sum == G) break;
        __builtin_amdgcn_s_sleep(1);
        if ((++sp & 255u) == 0u) { if (xb_ld(&bar[XB_TMO])) break; if (sp > XB_SPIN_CAP) { atomicAdd(&bar[XB_TMO], 1u); break; } }
    }
    nloc = mine > 0u ? mine : 1u; nx = cnt > 0u ? cnt : 1u;
}

__device__ __forceinline__ void xcd_barrier(const XcdBarrier& b) {
    asm volatile("s_waitcnt vmcnt(0)" ::: "memory");
    __syncthreads();
    if (threadIdx.x == 0) {
        unsigned* bar = b.bar;
        __builtin_amdgcn_s_waitcnt(0);
        unsigned nloc = b.st[0], nx = b.st[1];
        if (nloc == 0u) { xcd_barrier_complete(bar, b.x, nloc, nx); b.st[0] = nloc; b.st[1] = nx; }
        const unsigned old = xb_add(&bar[XB_XSUB(b.x)], 1u);
        const unsigned gen = old / nloc;
        if (old + 1u == (gen + 1u) * nloc) {
            __builtin_amdgcn_fence(__ATOMIC_RELEASE, "agent");
            asm volatile("s_waitcnt vmcnt(0)" ::: "memory");
            const unsigned og = xb_add(&bar[XB_TOP], 1u);
            const unsigned tg = og / nx;
            if (og + 1u == (tg + 1u) * nx) xb_add(&bar[XB_TOPGEN], 1u);
            else XB_SPIN(xb_ld(&bar[XB_TOPGEN]) == tg, bar);
            __builtin_amdgcn_fence(__ATOMIC_ACQUIRE, "agent");
            xb_add(&bar[XB_XGEN(b.x)], 1u);
            asm volatile("s_waitcnt vmcnt(0)" ::: "memory");
        } else {
            XB_SPIN(xb_ld(&bar[XB_XGEN(b.x)]) == gen, bar);
            __builtin_amdgcn_fence(__ATOMIC_ACQUIRE, "agent");
            asm volatile("s_waitcnt vmcnt(0)" ::: "memory");
        }
    }
    __syncthreads();
}

__global__ void __launch_bounds__(512, 2) fwd_mega(Args A) {
    extern __shared__ __attribute__((aligned(16))) unsigned char lds_raw[];
    LAS unsigned char* lds = (LAS unsigned char*)lds_raw;
    cg::grid_group grid = cg::this_grid();
    const int wv = __builtin_amdgcn_readfirstlane((int)threadIdx.x >> 6);
    const int G = gridDim.x;
    unsigned char* ws = A.ws;
    h16* X = (h16*)(ws + WS_X); h16* HP = (h16*)(ws + WS_HP);
    pg8::StaticOrder S; pg8::SplitTailOrder ST;
    volatile LAS unsigned* bst = (volatile LAS unsigned*)(lds + LDS_BYTES - 32);
    if (threadIdx.x == 0) { bst[0] = 0u; bst[1] = 0u; }
    __syncthreads();
    if (blockIdx.x == 0) { for (int i = threadIdx.x; i < 4096; i += 512) ((unsigned*)(ws + WS_BAR))[i] = 0u; }
    float* PART = (float*)(ws + WS_PART);

    p0_convert(wv, A, lds, G);
    grid.sync();
    const XcdBarrier xbar = xcd_barrier_post((unsigned*)(ws + WS_BAR), bst);
    {
        pg8::Gemm g{X, (const h16*)(ws + WS_WUP1), MT, 2 * DFF, DM}; S.init(MT, 2 * DFF, G, blockIdx.x); S.kt = DM / 64;
        pg8::gemm_phase(wv, lds, g, S, pg8::EpiSwiglu{HP});
        pg8::Gemm g2{(const h16*)(ws + WS_MEMH), (const h16*)(ws + WS_WMKV), 512, 1024, DM}; S.init(512, 1024, G, blockIdx.x); S.kt = DM / 64;
        pg8::gemm_phase(wv, lds, g2, S, pg8::EpiMemKV{A.out, (h16*)(ws + WS_MK16), (h16*)(ws + WS_MVT)});
    }
    xcd_barrier(xbar);
    {
        pg8::Gemm g{HP, (const h16*)(ws + WS_WDN1), MT, DM, DFF}; ST.init(DFF, G, blockIdx.x);
        pg8::gemm_phase(wv, lds, g, ST, pg8::EpiRes{X, DN_ALPHA, 0.5f, PART});
    }
    xcd_barrier(xbar);
    ln_phase(wv, X, A.in[10], A.in[11], nullptr, G, PART, DN_ALPHA, 0.5f);
    xcd_barrier(xbar);
    {
        pg8::Gemm g{X, (const h16*)(ws + WS_WIN), MT, PW, DM}; S.init(MT, PW, G, blockIdx.x); S.kt = DM / 64;
        pg8::gemm_phase(wv, lds, g, S, pg8::EpiProj{HP, A.out, (h16*)(ws + WS_KVC), (h16*)(ws + WS_KIC), ws + WS_KC8, ws + WS_VC8});
    }
    xcd_barrier(xbar);
    gla_prep(wv, A, lds, G);
    xcd_barrier(xbar);
    mixer_phase(wv, A, lds);
    xcd_barrier(xbar);
    gla_out_phase(wv, A, G);
    xcd_barrier(xbar);
    {
        pg8::Gemm g{(const h16*)(ws + WS_MIX), (const h16*)(ws + WS_WO), MT, DM, DM}; ST.init(DM, G, blockIdx.x);
        pg8::gemm_phase(wv, lds, g, ST, pg8::EpiRes{X, DN_ALPHA, 1.f, PART});
    }
    xcd_barrier(xbar);
    ln_phase(wv, X, A.in[10] + DM, A.in[11] + DM, nullptr, G, PART, DN_ALPHA, 1.f);
    xcd_barrier(xbar);
    {
        pg8::Gemm g{X, (const h16*)(ws + WS_WMQ), MT, 512, DM}; S.init(MT, 512, G, blockIdx.x); S.kt = DM / 64;
        pg8::gemm_phase(wv, lds, g, S, pg8::EpiPlain{(h16*)(ws + WS_MQ), 512});
    }
    xcd_barrier(xbar);
    mem_attn_phase(wv, A, lds, G);
    xcd_barrier(xbar);
    {
        pg8::Gemm g{(const h16*)(ws + WS_MO), (const h16*)(ws + WS_WMO), MT, DM, 512}; S.init(MT, DM, G, blockIdx.x); S.kt = 512 / 64;
        pg8::gemm_phase(wv, lds, g, S, pg8::EpiRes{X, DN_ALPHA, 1.f, nullptr});
    }
    xcd_barrier(xbar);
    ln_phase(wv, X, A.in[10] + 2 * DM, A.in[11] + 2 * DM, nullptr, G, nullptr, 0.f, 0.f);
    xcd_barrier(xbar);
    {
        pg8::Gemm g{X, (const h16*)(ws + WS_WUP2), MT, 2 * DFF, DM}; S.init(MT, 2 * DFF, G, blockIdx.x); S.kt = DM / 64;
        pg8::gemm_phase(wv, lds, g, S, pg8::EpiSwiglu{HP});
    }
    xcd_barrier(xbar);
    {
        pg8::Gemm g{HP, (const h16*)(ws + WS_WDN2), MT, DM, DFF}; ST.init(DFF, G, blockIdx.x);
        pg8::gemm_phase(wv, lds, g, ST, pg8::EpiRes{X, DN_ALPHA, 0.5f, PART});
    }
    xcd_barrier(xbar);
    ln_phase(wv, X, A.in[10] + 3 * DM, A.in[11] + 3 * DM, A.out + O_Y, G, PART, DN_ALPHA, 0.5f);
}

extern "C" void kernel_launch(void* const* d_in, const int* in_sizes, int n_in, void* d_out, int out_size, void* d_ws, size_t ws_size, hipStream_t stream) {
    static int grid = 0;
    if (grid == 0) {
        if (n_in != 27 || (size_t)out_size != O_END || ws_size < WS_END) { fprintf(stderr, "kernel_launch: unexpected shapes n_in %d out %d ws %zu\n", n_in, out_size, ws_size); grid = -1; return; }
        int dev = 0, cus = 0, per_cu = 0;
        hipGetDevice(&dev);
        hipDeviceGetAttribute(&cus, hipDeviceAttributeMultiprocessorCount, dev);
        if (hipFuncSetAttribute((const void*)fwd_mega, hipFuncAttributeMaxDynamicSharedMemorySize, LDS_BYTES) != hipSuccess) { fprintf(stderr, "kernel_launch: hipFuncSetAttribute failed\n"); grid = -1; return; }
        hipOccupancyMaxActiveBlocksPerMultiprocessor(&per_cu, (const void*)fwd_mega, 512, LDS_BYTES);
        if (per_cu < 1) { fprintf(stderr, "kernel_launch: occupancy query says %d\n", per_cu); per_cu = 1; }
        (void)hipGetLastError();
        grid = cus * per_cu;
    }
    if (grid < 0) return;
    Args a{};
    for (int i = 0; i < 27; ++i) a.in[i] = (const float*)d_in[i];
    a.out = (float*)d_out; a.ws = (unsigned char*)d_ws;
    void* args[] = {&a};
    hipError_t e = hipLaunchCooperativeKernel((const void*)fwd_mega, dim3(grid), dim3(512), args, LDS_BYTES, stream);
    if (e != hipSuccess) fprintf(stderr, "cooperative launch failed: %s (grid %d)\n", hipGetErrorString(e), grid);
}
```

```cpp
#include <hip/hip_runtime.h>
#include <hip/hip_cooperative_groups.h>
#include <cstdio>
#include <cstdint>
namespace cg = cooperative_groups;

#define LAS __attribute__((address_space(3)))
typedef _Float16 h16;
typedef _Float16 h16x8 __attribute__((ext_vector_type(8)));
typedef _Float16 h16x4 __attribute__((ext_vector_type(4)));
typedef _Float16 h16x2 __attribute__((ext_vector_type(2)));
typedef float f32x4 __attribute__((ext_vector_type(4)));
typedef float f32x2 __attribute__((ext_vector_type(2)));
typedef unsigned u32x4 __attribute__((ext_vector_type(4)));
typedef unsigned u32x2 __attribute__((ext_vector_type(2)));

constexpr int DM = 2048, NP = 32768, NS = 512, MT = NP + NS  , DFF = 5632;
constexpr int SEQ = 16384, PAST = 1024;
constexpr int PW = 5888;
constexpr int C_Q = 0, C_K = 1024, C_V = 1280, C_QI = 1536, C_KI = 2560, C_WI = 2624, C_GLR = 2640, C_GQ = 2816, C_GK = 3328, C_GV = 3840, C_GR = 4864;
constexpr float DN_ALPHA = 1.189207115002721f;
constexpr float LN_EPS = 1e-5f;
constexpr float RS128 = 0.08838834764831845f;

constexpr size_t O_Y = 0;
constexpr size_t O_KP = (size_t)MT * DM;
constexpr size_t O_VP = O_KP + (size_t)NP * 256;
constexpr size_t O_KIP = O_VP + (size_t)NP * 256;
constexpr size_t O_SP = O_KIP + (size_t)NP * 64;
constexpr size_t O_MKP = O_SP + (size_t)2 * 4 * 128 * 256;
constexpr size_t O_MVP = O_MKP + (size_t)2 * 256 * 512;
constexpr size_t O_KS = O_MVP + (size_t)2 * 256 * 512;
constexpr size_t O_VS = O_KS + (size_t)NS * 256;
constexpr size_t O_KIS = O_VS + (size_t)NS * 256;
constexpr size_t O_SS = O_KIS + (size_t)NS * 64;
constexpr size_t O_END = O_SS + (size_t)8 * 4 * 128 * 256;
static_assert(O_END == 89161728, "out size");

constexpr size_t WS_CTL = 0;
constexpr size_t WS_WUP1 = 4096;
constexpr size_t WS_WDN1 = WS_WUP1 + (size_t)2 * DFF * DM * 2;
constexpr size_t WS_WUP2 = WS_WDN1 + (size_t)DM * DFF * 2;
constexpr size_t WS_WDN2 = WS_WUP2 + (size_t)2 * DFF * DM * 2;
constexpr size_t WS_WIN = WS_WDN2 + (size_t)DM * DFF * 2;
constexpr size_t WS_WO = WS_WIN + (size_t)PW * DM * 2;
constexpr size_t WS_WMQ = WS_WO + (size_t)DM * DM * 2;
constexpr size_t WS_WMO = WS_WMQ + (size_t)512 * DM * 2;
constexpr size_t WS_WMKV = WS_WMO + (size_t)DM * 512 * 2;
constexpr size_t WS_X = WS_WMKV + (size_t)1024 * DM * 2;
constexpr size_t WS_HP = WS_X + (size_t)MT * DM * 2;
constexpr size_t WS_MIX = WS_HP + (size_t)MT * PW * 2;
constexpr size_t WS_QT = WS_MIX + (size_t)MT * DM * 2;
constexpr size_t WS_KT = WS_QT + (size_t)MT * 512 * 2;
constexpr size_t WS_KTT = WS_KT + (size_t)MT * 512 * 2;
constexpr size_t WS_VT = WS_KTT + (size_t)MT * 512 * 2;
constexpr size_t WS_ER = WS_VT + (size_t)MT * 1024 * 2;
constexpr size_t WS_DEC = WS_ER + (size_t)520 * 512 * 4;
constexpr size_t WS_FF = WS_DEC + (size_t)520 * 512 * 4;
constexpr size_t WS_MEMH = WS_FF + (size_t)520 * 512 * 4;
constexpr size_t WS_MK16 = WS_MEMH + (size_t)512 * DM * 2;
constexpr size_t WS_MVT = WS_MK16 + (size_t)512 * 512 * 2;
constexpr size_t WS_CK = WS_MVT + (size_t)512 * 512 * 2;
constexpr size_t WS_CV = WS_CK + (size_t)8192 * 256 * 2;
constexpr size_t WS_CKI = WS_CV + (size_t)8192 * 256 * 2;
constexpr size_t WS_CMK = WS_CKI + (size_t)8192 * 64 * 2;
constexpr size_t WS_CMVT = WS_CMK + (size_t)2048 * 512 * 2;
constexpr size_t WS_PART = WS_CMVT + (size_t)2048 * 512 * 2;
constexpr size_t WS_BAR = WS_PART + (size_t)4 * NS * DM * 4;
constexpr size_t WS_END = WS_BAR + 16384;
constexpr size_t WS_KVC = WS_WUP1;
constexpr size_t WS_KIC = WS_KVC + (size_t)MT * 512 * 2;
constexpr size_t WS_KC8 = WS_KIC + (size_t)MT * 64 * 2;
static_assert(WS_KC8 + (size_t)MT * 256 <= WS_WUP2, "compact tables overlay (dead FFN1 weight copies)");
constexpr size_t WS_VC8 = WS_KC8 + (size_t)MT * 256;
static_assert(WS_VC8 + (size_t)MT * 256 <= WS_WUP2, "compact tables overlay");
constexpr size_t WS_CV8 = WS_BAR + 16384 + (size_t)8192 * 256;
static_assert(WS_CV8 + (size_t)8192 * 256 <= (size_t)1073741824, "ws map");
constexpr size_t WS_CK8 = WS_BAR + 16384;
static_assert(WS_CK8 + (size_t)8192 * 256 <= (size_t)1073741824, "ws map");
constexpr size_t WS_MQ = WS_QT;
constexpr size_t WS_MO = WS_KT;
static_assert(WS_END <= (size_t)1073741824, "ws map");

constexpr int LDS_BYTES = 155648;

struct Args { const float* in[27]; float* out; unsigned char* ws; };

__device__ __forceinline__ float wave_sum(float v) {
#pragma unroll
    for (int o = 1; o < 64; o <<= 1) v += __shfl_xor(v, o);
    return v;
}
__device__ __forceinline__ float wave_max(float v) {
#pragma unroll
    for (int o = 1; o < 64; o <<= 1) v = fmaxf(v, __shfl_xor(v, o));
    return v;
}
#define LDS_WAIT() asm volatile("s_waitcnt lgkmcnt(0)" ::: "memory")
__device__ __forceinline__ int opaque_tid(int wv) { int t = wv * 64 + (int)__builtin_amdgcn_mbcnt_hi(~0u, __builtin_amdgcn_mbcnt_lo(~0u, 0u)); asm volatile("" : "+v"(t)); return t; }

__device__ __forceinline__ u32x2 pack_fp8x8(const f32x4 a, const f32x4 b) {
    int lo = 0, hi = 0;
    lo = __builtin_amdgcn_cvt_pk_fp8_f32(a[0], a[1], lo, false); lo = __builtin_amdgcn_cvt_pk_fp8_f32(a[2], a[3], lo, true);
    hi = __builtin_amdgcn_cvt_pk_fp8_f32(b[0], b[1], hi, false); hi = __builtin_amdgcn_cvt_pk_fp8_f32(b[2], b[3], hi, true);
    u32x2 r; r[0] = (unsigned)lo; r[1] = (unsigned)hi; return r;
}
namespace pg8 {
constexpr int BM = 256, BK = 64, HALF = 128, HTB = HALF * BK * 2, STAGE_BYTES = 8 * HTB, NXCD = 8, WGM = 8;
__device__ __forceinline__ int lds_byte(int r, int c) { const int st = (r >> 4) * 2 + (c >> 5), rr = r & 15, cc = c & 31, ob = rr * 64 + cc * 2; return st * 1024 + (ob ^ (((ob >> 9) & 1) << 5)); }
__device__ __forceinline__ void stage_rc(int b, int& R, int& C) { const int st = b / 1024, sb = b % 1024, swz = sb ^ (((sb >> 9) & 1) << 5); R = (st >> 1) * 16 + swz / 64; C = (st & 1) * 32 + (swz % 64) / 2; }
__device__ __forceinline__ int perm32(int rho) { const int n = rho >> 4, i = rho & 15; return 8 * (i >> 2) + 4 * n + (i & 3); }
struct Unit { int pm, pn, nt, ks; size_t koff; };
struct Gemm { const h16* A; const h16* Bt; int M, N, K; };
struct StaticOrder {
    int nM, nN, nwg, G, c;
    __device__ void init(int M, int N, int G_, int c_) { nM = M / BM; nN = N / BM; nwg = nM * nN; G = G_; c = c_; kt = 0; }
    __device__ bool next(int i, Unit& u) const {
        const long L = (long)i * G + c; if (L >= nwg) return false;
        int wgid = (int)L; { const int q = nwg / NXCD, r = nwg % NXCD, xcd = wgid % NXCD, off = wgid / NXCD; wgid = (xcd < r ? xcd * (q + 1) : r * (q + 1) + (xcd - r) * q) + off; }
        const int nig = WGM * nN, gid = wgid / nig, fm = gid * WGM, gsz = (nM - fm) < WGM ? (nM - fm) : WGM;
        u.pm = fm + ((wgid % nig) % gsz); u.pn = (wgid % nig) / gsz; u.nt = kt; u.ks = -1; u.koff = 0; return true;
    }
    int kt;
};
struct SplitTailOrder {
    StaticOrder P; int G, c, K;
    __device__ void init(int K_, int G_, int c_) { P.init(NP, 2048, G_, c_); P.kt = K_ / BK; G = G_; c = c_; K = K_; }
    __device__ bool next(int i, Unit& u) const {
        if (P.next(i, u)) return true;
        const long L = (long)i * G + c - P.nwg; if (L < 0 || L >= 64) return false;
        const int j = (int)L; u.pm = 128 + (j >> 5); u.pn = (j >> 2) & 7; u.ks = j & 3; u.nt = K / BK / 4; u.koff = (size_t)u.ks * (K / 4) * 2; return true;
    }
};
__device__ __forceinline__ u32x4 pack8(const f32x4 a, const f32x4 b) {
    h16x8 h; h[0] = (h16)a[0]; h[1] = (h16)a[1]; h[2] = (h16)a[2]; h[3] = (h16)a[3]; h[4] = (h16)b[0]; h[5] = (h16)b[1]; h[6] = (h16)b[2]; h[7] = (h16)b[3];
    return __builtin_bit_cast(u32x4, h);
}
struct EpiSwiglu {
    h16* H;
    __device__ __forceinline__ void operator()(const f32x4 (&acc)[2][2][4][2], const Unit& u, int wr, int wc, int fr, int fq) const {
        const int row0 = u.pm * BM + wr * 64 + fr, col0 = u.pn * 128 + wc * 32 + 8 * fq;
#pragma unroll
        for (int ai = 0; ai < 2; ++ai)
#pragma unroll
            for (int m = 0; m < 4; ++m) {
                f32x4 o[2];
#pragma unroll
                for (int n = 0; n < 2; ++n)
#pragma unroll
                    for (int j = 0; j < 4; ++j) { const float g = acc[ai][0][m][n][j], up = acc[ai][1][m][n][j]; o[n][j] = g * __builtin_amdgcn_rcpf(1.f + __expf(-g)) * up; }
                *(u32x4*)(H + (size_t)(row0 + ai * HALF + m * 16) * DFF + col0) = pack8(o[0], o[1]);
            }
    }
};
struct EpiRes {
    h16* X; float alpha, beta; float* part;
    __device__ __forceinline__ void operator()(const f32x4 (&acc)[2][2][4][2], const Unit& u, int wr, int wc, int fr, int fq) const {
        const int row0 = u.pm * BM + wr * 64 + fr, col0 = u.pn * BM + wc * 32 + 8 * fq;
        if (u.ks >= 0) {
#pragma unroll
            for (int ai = 0; ai < 2; ++ai)
#pragma unroll
                for (int m = 0; m < 4; ++m)
#pragma unroll
                    for (int bj = 0; bj < 2; ++bj) { float* d = part + ((size_t)u.ks * NS + (row0 + ai * HALF + m * 16 - NP)) * DM + col0 + bj * HALF;
                        *(f32x4*)d = acc[ai][bj][m][0]; *(f32x4*)(d + 4) = acc[ai][bj][m][1]; }
            return;
        }
#pragma unroll
        for (int ai = 0; ai < 2; ++ai) {
            u32x4 res[4][2];
#pragma unroll
            for (int m = 0; m < 4; ++m)
#pragma unroll
                for (int bj = 0; bj < 2; ++bj) res[m][bj] = *(const u32x4*)(X + (size_t)(row0 + ai * HALF + m * 16) * DM + col0 + bj * HALF);
#pragma unroll
            for (int m = 0; m < 4; ++m)
#pragma unroll
                for (int bj = 0; bj < 2; ++bj) {
                    h16* p = X + (size_t)(row0 + ai * HALF + m * 16) * DM + col0 + bj * HALF;
                    const h16x8 r = __builtin_bit_cast(h16x8, res[m][bj]);
                    f32x4 o0, o1;
#pragma unroll
                    for (int j = 0; j < 4; ++j) { o0[j] = alpha * (float)r[j] + beta * acc[ai][bj][m][0][j]; o1[j] = alpha * (float)r[4 + j] + beta * acc[ai][bj][m][1][j]; }
                    *(u32x4*)p = pack8(o0, o1);
                }
        }
    }
};
struct EpiPlain {
    h16* O; int ld;
    __device__ __forceinline__ void operator()(const f32x4 (&acc)[2][2][4][2], const Unit& u, int wr, int wc, int fr, int fq) const {
        const int row0 = u.pm * BM + wr * 64 + fr, col0 = u.pn * BM + wc * 32 + 8 * fq;
#pragma unroll
        for (int ai = 0; ai < 2; ++ai)
#pragma unroll
            for (int m = 0; m < 4; ++m)
#pragma unroll
                for (int bj = 0; bj < 2; ++bj)
                    *(u32x4*)(O + (size_t)(row0 + ai * HALF + m * 16) * ld + col0 + bj * HALF) = pack8(acc[ai][bj][m][0], acc[ai][bj][m][1]);
    }
};
struct EpiProj {
    h16* O; float* out; h16* KVC; h16* KIC; unsigned char* KC8; unsigned char* VC8;
    __device__ __forceinline__ void operator()(const f32x4 (&acc)[2][2][4][2], const Unit& u, int wr, int wc, int fr, int fq) const {
        const int row0 = u.pm * BM + wr * 64 + fr, col0 = u.pn * BM + wc * 32 + 8 * fq;
        const bool prompt = u.pm < 128;
#pragma unroll
        for (int ai = 0; ai < 2; ++ai)
#pragma unroll
            for (int m = 0; m < 4; ++m)
#pragma unroll
                for (int bj = 0; bj < 2; ++bj) {
                    const int row = row0 + ai * HALF + m * 16, col = col0 + bj * HALF;
                    if (u.pn != 4 && u.pn != 5) *(u32x4*)(O + (size_t)row * PW + col) = pack8(acc[ai][bj][m][0], acc[ai][bj][m][1]);
                    float* d = nullptr;
                    const int rr = prompt ? row : row - NP;
                    if (u.pn == 4) { d = out + (prompt ? O_KP : O_KS) + (size_t)rr * 256 + (col - C_K); *(u32x2*)(KC8 + (size_t)row * 256 + (col - C_K)) = pack_fp8x8(acc[ai][bj][m][0], acc[ai][bj][m][1]); }
                    else if (u.pn == 5) { d = out + (prompt ? O_VP : O_VS) + (size_t)rr * 256 + (col - C_V); *(u32x2*)(VC8 + (size_t)row * 256 + (col - C_V)) = pack_fp8x8(acc[ai][bj][m][0], acc[ai][bj][m][1]); }
                    else if (u.pn == 10 && col < C_KI + 64) { d = out + (prompt ? O_KIP : O_KIS) + (size_t)rr * 64 + (col - C_KI); *(u32x4*)(KIC + (size_t)row * 64 + (col - C_KI)) = pack8(acc[ai][bj][m][0], acc[ai][bj][m][1]); }
                    if (d) { *(f32x4*)d = acc[ai][bj][m][0]; *(f32x4*)(d + 4) = acc[ai][bj][m][1]; }
                }
    }
};
struct EpiMemKV {
    float* out; h16* MK; h16* MVT;
    __device__ __forceinline__ void operator()(const f32x4 (&acc)[2][2][4][2], const Unit& u, int wr, int wc, int fr, int fq) const {
        const int row0 = u.pm * BM + wr * 64 + fr, col0 = u.pn * BM + wc * 32 + 8 * fq;
#pragma unroll
        for (int ai = 0; ai < 2; ++ai)
#pragma unroll
            for (int m = 0; m < 4; ++m)
#pragma unroll
                for (int bj = 0; bj < 2; ++bj) {
                    const int row = row0 + ai * HALF + m * 16, col = col0 + bj * HALF;
                    if (col < 512) {
                        float* d = out + O_MKP + (size_t)row * 512 + col;
                        *(f32x4*)d = acc[ai][bj][m][0]; *(f32x4*)(d + 4) = acc[ai][bj][m][1];
                        *(u32x4*)(MK + (size_t)row * 512 + col) = pack8(acc[ai][bj][m][0], acc[ai][bj][m][1]);
                    } else {
                        const int c2 = col - 512;
                        float* d = out + O_MVP + (size_t)row * 512 + c2;
                        *(f32x4*)d = acc[ai][bj][m][0]; *(f32x4*)(d + 4) = acc[ai][bj][m][1];
                        const int b = row >> 8, nn = row & 255;
#pragma unroll
                        for (int n = 0; n < 2; ++n)
#pragma unroll
                            for (int j = 0; j < 4; ++j) { const int cc = c2 + 4 * n + j; MVT[((size_t)(b * 4 + (cc >> 7)) * 128 + (cc & 127)) * 256 + nn] = (h16)acc[ai][bj][m][n][j]; }
                    }
                }
    }
};

template <class Epi, class Order>
__device__ __forceinline__ void gemm_phase(int wv, LAS unsigned char* lds, const Gemm g, const Order& S, const Epi& E) {
    const int tid = opaque_tid(wv), wid = __builtin_amdgcn_readfirstlane(tid >> 6), lane = tid & 63, wr = wid >> 2, wc = wid & 3, fr = lane & 15, fq = lane >> 4;
    const int K = g.K;
    unsigned voffA[2], voffB[2];
#pragma unroll
    for (int i = 0; i < 2; ++i) { int R, C; stage_rc(tid * 16 + i * 8192, R, C); const int Rb = (R & ~31) + perm32(R & 31);
        voffA[i] = (unsigned)(R * K + C) * 2u; voffB[i] = (unsigned)(Rb * K + C) * 2u; }
    const size_t kstep = (size_t)(BK * 2);
    const size_t hstep = (size_t)HALF * K * 2;
    const size_t tstep = 2 * hstep;
    const unsigned ldsw = (unsigned)wid * 1024u;
    const int aoff = lds_byte(wr * 64 + fr, fq * 8), boff = lds_byte(wc * 32 + fr, fq * 8);
#define PG8_SA(b, h) (((b) * 2 + (h)) * HTB)
#define PG8_SB(b, h) ((4 + (b) * 2 + (h)) * HTB)
#define PG8_STAGE(bufoff, gbase, voff) do { _Pragma("unroll") for (int _i = 0; _i < 2; ++_i) \
        __builtin_amdgcn_global_load_lds((const unsigned*)((const char*)(gbase) + (voff)[_i]), (LAS unsigned*)(lds + (bufoff) + ldsw + _i * 8192), 16, 0, 0); } while (0)
#define PG8_LDA(dst, b, h) do { _Pragma("unroll") for (int m = 0; m < 4; ++m) _Pragma("unroll") for (int k = 0; k < 2; ++k) dst[m][k] = *(const LAS h16x8*)(lds + PG8_SA(b, h) + aoff + m * 2048 + k * 1024); } while (0)
#define PG8_LDB(dst, b, h) do { _Pragma("unroll") for (int n = 0; n < 2; ++n) _Pragma("unroll") for (int k = 0; k < 2; ++k) dst[n][k] = *(const LAS h16x8*)(lds + PG8_SB(b, h) + boff + n * 2048 + k * 1024); } while (0)
#define PG8_MMA(ai, bj, At, Bt) do { __builtin_amdgcn_s_setprio(1); _Pragma("unroll") for (int m = 0; m < 4; ++m) _Pragma("unroll") for (int n = 0; n < 2; ++n) _Pragma("unroll") for (int k = 0; k < 2; ++k) \
        acc[ai][bj][m][n] = __builtin_amdgcn_mfma_f32_16x16x32_f16(Bt[n][k], At[m][k], acc[ai][bj][m][n], 0, 0, 0); __builtin_amdgcn_s_setprio(0); } while (0)
#define PG8_WAIT_V(n) asm volatile("s_waitcnt vmcnt(" #n ")" ::: "memory")
#define PG8_WAIT_L(n) asm volatile("s_waitcnt lgkmcnt(" #n ")" ::: "memory")
#define PG8_BAR __builtin_amdgcn_s_barrier()
#define PG8_SCHED __builtin_amdgcn_sched_barrier(0)
    Unit cur, nxt; int ui = 0;
    if (!S.next(0, cur)) return;
    f32x4 acc[2][2][4][2];
#pragma unroll
    for (int a = 0; a < 2; ++a)
#pragma unroll
        for (int b = 0; b < 2; ++b)
#pragma unroll
            for (int m = 0; m < 4; ++m)
#pragma unroll
                for (int n = 0; n < 2; ++n) acc[a][b][m][n] = (f32x4){0.f, 0.f, 0.f, 0.f};
    h16x8 At[4][2], B0[2][2], B1[2][2];
    const char* cA = (const char*)g.A + (size_t)cur.pm * tstep + cur.koff; const char* cB = (const char*)g.Bt + (size_t)cur.pn * tstep + cur.koff;
    PG8_STAGE(PG8_SB(0, 0), cB, voffB); PG8_STAGE(PG8_SB(0, 1), cB + hstep, voffB); PG8_STAGE(PG8_SA(0, 0), cA, voffA); PG8_STAGE(PG8_SA(0, 1), cA + hstep, voffA);
    if (wr == 1) PG8_BAR;
    PG8_WAIT_V(2); PG8_BAR;
    PG8_STAGE(PG8_SB(1, 0), cB + kstep, voffB); PG8_STAGE(PG8_SA(1, 0), cA + kstep, voffA); PG8_STAGE(PG8_SB(1, 1), cB + hstep + kstep, voffB);
    PG8_WAIT_V(6); PG8_BAR;
    for (;;) {
        const bool has_next = S.next(ui + 1, nxt);
        const char* nA = has_next ? (const char*)g.A + (size_t)nxt.pm * tstep + nxt.koff : cA; const char* nB = has_next ? (const char*)g.Bt + (size_t)nxt.pn * tstep + nxt.koff : cB;
        const int nt = cur.nt;
        for (int t = 0; t < nt; t += 2) {
            const bool last = (t == nt - 2);
            const char* a1 = cA + (size_t)(t + 1) * kstep;
            const char* a2 = last ? nA : cA + (size_t)(t + 2) * kstep; const char* b2 = last ? nB : cB + (size_t)(t + 2) * kstep;
            const char* a3 = a2 + kstep; const char* b3 = b2 + kstep;
            PG8_LDB(B0, 0, 0); PG8_LDB(B1, 0, 1); PG8_SCHED; PG8_LDA(At, 0, 0); PG8_STAGE(PG8_SA(1, 1), a1 + hstep, voffA);
            PG8_WAIT_V(8); PG8_WAIT_L(0); PG8_BAR; PG8_MMA(0, 0, At, B0); PG8_MMA(0, 1, At, B1); PG8_BAR; PG8_SCHED;
            PG8_LDA(At, 0, 1); PG8_STAGE(PG8_SB(0, 0), b2, voffB); PG8_STAGE(PG8_SB(0, 1), b2 + hstep, voffB); PG8_STAGE(PG8_SA(0, 0), a2, voffA);
            PG8_WAIT_V(8); PG8_WAIT_L(0); PG8_BAR; PG8_MMA(1, 0, At, B0); PG8_MMA(1, 1, At, B1); PG8_BAR; PG8_SCHED;
            PG8_LDB(B0, 1, 0); PG8_LDB(B1, 1, 1); PG8_SCHED; PG8_LDA(At, 1, 0); PG8_STAGE(PG8_SA(0, 1), a2 + hstep, voffA);
            PG8_WAIT_V(8); PG8_WAIT_L(0); PG8_BAR; PG8_MMA(0, 0, At, B0); PG8_MMA(0, 1, At, B1); PG8_BAR; PG8_SCHED;
            PG8_LDA(At, 1, 1); PG8_STAGE(PG8_SB(1, 0), b3, voffB); PG8_STAGE(PG8_SB(1, 1), b3 + hstep, voffB); PG8_STAGE(PG8_SA(1, 0), a3, voffA);
            PG8_WAIT_V(8); PG8_WAIT_L(0); PG8_BAR; PG8_MMA(1, 0, At, B0); PG8_MMA(1, 1, At, B1); PG8_BAR; PG8_SCHED;
        }
        if (wr == 0) PG8_BAR;
        E(acc, cur, wr, wc, fr, fq);
        if (!has_next) break;
#pragma unroll
        for (int a = 0; a < 2; ++a)
#pragma unroll
            for (int b = 0; b < 2; ++b)
#pragma unroll
                for (int m = 0; m < 4; ++m)
#pragma unroll
                    for (int n = 0; n < 2; ++n) acc[a][b][m][n] = (f32x4){0.f, 0.f, 0.f, 0.f};
        cur = nxt; cA = nA; cB = nB; ++ui;
        if (wr == 1) PG8_BAR;
    }
    PG8_WAIT_V(0);
    PG8_BAR;
#undef PG8_SA
#undef PG8_SB
#undef PG8_STAGE
#undef PG8_LDA
#undef PG8_LDB
#undef PG8_MMA
#undef PG8_WAIT_V
#undef PG8_WAIT_L
#undef PG8_BAR
#undef PG8_SCHED
}
}

__device__ __forceinline__ void tr_item(const float* colp, int ld, float sc, int K, h16* WT, LAS float* scr, int k0, int n0, int lane) {
    const int cg = lane & 15;
#pragma unroll
    for (int i = 0; i < 16; ++i) { const int kk = 4 * i + (lane >> 4);
        f32x4 v = {0.f, 0.f, 0.f, 0.f}; if (colp) v = *(const f32x4*)(colp + (size_t)(k0 + kk) * ld) * sc;
        LAS float* d = scr + kk * 65 + 4 * cg; d[0] = v[0]; d[1] = v[1]; d[2] = v[2]; d[3] = v[3]; }
    LDS_WAIT(); asm volatile("" ::: "memory");
    const int c = lane & 7;
#pragma unroll
    for (int j = 0; j < 8; ++j) { const int n = (lane >> 3) + 8 * j; const LAS float* s = scr + (8 * c) * 65 + n;
        h16x8 o;
#pragma unroll
        for (int e = 0; e < 8; ++e) o[e] = (h16)s[e * 65];
        *(u32x4*)(WT + (size_t)(n0 + n) * K + k0 + 8 * c) = __builtin_bit_cast(u32x4, o); }
    LDS_WAIT(); asm volatile("" ::: "memory");
}
__device__ __forceinline__ void cvt_copy(const float* src, h16* dst, size_t n8, size_t gt, size_t ngt) {
    for (size_t i = gt; i < n8; i += ngt) { const f32x4 a = *(const f32x4*)(src + i * 8), b = *(const f32x4*)(src + i * 8 + 4); *(u32x4*)(dst + i * 8) = pg8::pack8(a, b); }
}
__device__ __forceinline__ void p0_convert(int wv, const Args& A, LAS unsigned char* lds, int G) {
    const int tid = opaque_tid(wv), lane = tid & 63, wave = tid >> 6;
    unsigned char* ws = A.ws;
    LAS float* scr = (LAS float*)(lds + wave * 16640);
    const int gw = blockIdx.x * 8 + wave, NGW = G * 8;
    constexpr int I_UP = 32 * 176, I_DN = 88 * 32, I_IN = 32 * 92, I_O = 32 * 32, I_MQ = 32 * 8, I_MO = 8 * 32, I_MKV = 32 * 16;
    constexpr int NITEMS = 2 * (I_UP + I_DN) + I_IN + I_O + I_MQ + I_MO + I_MKV;
    for (int it = gw; it < NITEMS; it += NGW) {
        int r = it; const float* colp = nullptr; int ld = 0, K = 2048, nblk = 1; float sc = 1.f; h16* WT = nullptr;
        int mode;
        if (r < I_UP) mode = 0; else if ((r -= I_UP) < I_DN) mode = 1; else if ((r -= I_DN) < I_UP) mode = 2; else if ((r -= I_UP) < I_DN) mode = 3;
        else if ((r -= I_DN) < I_IN) mode = 4; else if ((r -= I_IN) < I_O) mode = 5; else if ((r -= I_O) < I_MQ) mode = 6; else if ((r -= I_MQ) < I_MO) mode = 7; else { r -= I_MO; mode = 8; }
        switch (mode) { case 0: case 2: nblk = 176; break; case 1: case 3: nblk = 32; K = DFF; break; case 4: nblk = 92; break; case 5: nblk = 32; break; case 6: nblk = 8; break; case 7: nblk = 32; K = 512; break; default: nblk = 16; break; }
        const int kb = r / nblk, nb = r % nblk, k0 = 64 * kb, n0 = 64 * nb, n = n0 + 4 * (lane & 15);
        switch (mode) {
            case 0: case 2: { const int pn = n >> 8, w = n & 255; colp = A.in[(mode == 0 ? 12 : 24) + (w < 128 ? 0 : 1)] + 128 * pn + (w & 127); ld = DFF; WT = (h16*)(ws + (mode == 0 ? WS_WUP1 : WS_WUP2)); break; }
            case 1: case 3: colp = A.in[mode == 1 ? 14 : 26] + n; ld = DM; WT = (h16*)(ws + (mode == 1 ? WS_WDN1 : WS_WDN2)); break;
            case 4: { int oc;
                if (n < C_GLR) oc = n; else if (n < C_GLR + 16) oc = 4688 + (n - C_GLR); else if (n < C_GQ) oc = -1; else if (n < C_GK) oc = 2640 + (n - C_GQ);
                else if (n < C_GV) oc = 3152 + (n - C_GK); else if (n < C_GR) oc = 3664 + (n - C_GV); else oc = 4704 + (n - C_GR);
                colp = oc >= 0 ? A.in[15] + oc : nullptr; ld = 5728; if (n < 1024 || (n >= C_GQ && n < C_GK)) sc = RS128; WT = (h16*)(ws + WS_WIN); break; }
            case 5: colp = A.in[19] + n; ld = DM; WT = (h16*)(ws + WS_WO); break;
            case 6: colp = A.in[20] + n; ld = 512; sc = RS128; WT = (h16*)(ws + WS_WMQ); break;
            case 7: colp = A.in[23] + n; ld = DM; WT = (h16*)(ws + WS_WMO); break;
            default: colp = (n < 512) ? A.in[21] + n : A.in[22] + (n - 512); ld = 512; WT = (h16*)(ws + WS_WMKV); break;
        }
        tr_item(colp, ld, sc, K, WT, scr, k0, n0, lane);
    }
    const size_t gt = (size_t)blockIdx.x * 512 + tid, ngt = (size_t)G * 512;
    cvt_copy(A.in[0], (h16*)(ws + WS_X), (size_t)NP * DM / 8, gt, ngt);
    cvt_copy(A.in[1], (h16*)(ws + WS_X) + (size_t)NP * DM, (size_t)NS * DM / 8, gt, ngt);
    cvt_copy(A.in[8], (h16*)(ws + WS_MEMH), (size_t)512 * DM / 8, gt, ngt);
    cvt_copy(A.in[2], (h16*)(ws + WS_CK), (size_t)8192 * 256 / 8, gt, ngt);
    cvt_copy(A.in[3], (h16*)(ws + WS_CV), (size_t)8192 * 256 / 8, gt, ngt);
    cvt_copy(A.in[4], (h16*)(ws + WS_CKI), (size_t)8192 * 64 / 8, gt, ngt);
    for (size_t i = gt; i < (size_t)8192 * 256 / 8; i += ngt) { const f32x4 a = *(const f32x4*)(A.in[2] + i * 8), b = *(const f32x4*)(A.in[2] + i * 8 + 4); *(u32x2*)(ws + WS_CK8 + i * 8) = pack_fp8x8(a, b);
        const f32x4 c = *(const f32x4*)(A.in[3] + i * 8), d = *(const f32x4*)(A.in[3] + i * 8 + 4); *(u32x2*)(ws + WS_CV8 + i * 8) = pack_fp8x8(c, d); }
    cvt_copy(A.in[6], (h16*)(ws + WS_CMK), (size_t)2048 * 512 / 8, gt, ngt);
    for (size_t i = gt; i < (size_t)8 * 4 * 128 * 32; i += ngt) {
        const int n0 = (int)(i & 31) * 8, d = (int)(i >> 5) & 127, hh = (int)(i >> 12) & 3, bs = (int)(i >> 14);
        h16x8 o;
#pragma unroll
        for (int e = 0; e < 8; ++e) o[e] = (h16)A.in[7][((size_t)(bs * 256 + n0 + e) * 4 + hh) * 128 + d];
        *(u32x4*)((h16*)(ws + WS_CMVT) + ((size_t)(bs * 4 + hh) * 128 + d) * 256 + n0) = __builtin_bit_cast(u32x4, o);
    }
    if (blockIdx.x == 0 && tid < 64) ((unsigned*)(ws + WS_CTL))[tid] = 0u;
}

__device__ __forceinline__ void ln_phase(int wv, h16* X, const float* g, const float* b, float* out32, int G, const float* part, float alpha, float beta) {
    const int tid_ = opaque_tid(wv); const int lane = tid_ & 63, wave = tid_ >> 6;
    u32x4 nx[4];
    { const int r0 = blockIdx.x * 8 + wave; if (r0 < MT) {
#pragma unroll
        for (int j = 0; j < 4; ++j) nx[j] = *(const u32x4*)(X + (size_t)r0 * DM + j * 512 + lane * 8); } }
    for (int row = blockIdx.x * 8 + wave; row < MT; row += G * 8) {
        h16* xr = X + (size_t)row * DM;
        u32x4 cu[4];
#pragma unroll
        for (int j = 0; j < 4; ++j) cu[j] = nx[j];
        { const int rn = row + G * 8; if (rn < MT) {
#pragma unroll
            for (int j = 0; j < 4; ++j) nx[j] = *(const u32x4*)(X + (size_t)rn * DM + j * 512 + lane * 8); } }
        float v[32]; float s = 0.f;
#pragma unroll
        for (int j = 0; j < 4; ++j) { const h16x8 h = __builtin_bit_cast(h16x8, cu[j]);
#pragma unroll
            for (int e = 0; e < 8; ++e) v[j * 8 + e] = (float)h[e]; }
        if (part && row >= NP) {
#pragma unroll
            for (int j = 0; j < 4; ++j) { f32x4 a0 = {0.f, 0.f, 0.f, 0.f}, a1 = {0.f, 0.f, 0.f, 0.f};
#pragma unroll
                for (int ks = 0; ks < 4; ++ks) { const float* p = part + ((size_t)ks * NS + (row - NP)) * DM + j * 512 + lane * 8; a0 += *(const f32x4*)p; a1 += *(const f32x4*)(p + 4); }
#pragma unroll
                for (int e = 0; e < 4; ++e) { v[j * 8 + e] = alpha * v[j * 8 + e] + beta * a0[e]; v[j * 8 + 4 + e] = alpha * v[j * 8 + 4 + e] + beta * a1[e]; } } }
#pragma unroll
        for (int e = 0; e < 32; ++e) s += v[e];
        const float mean = wave_sum(s) * (1.f / DM); float s2 = 0.f;
#pragma unroll
        for (int e = 0; e < 32; ++e) { v[e] -= mean; s2 += v[e] * v[e]; }
        const float rstd = 1.f / sqrtf(wave_sum(s2) * (1.f / DM) + LN_EPS);
#pragma unroll
        for (int j = 0; j < 4; ++j) { const int c0 = j * 512 + lane * 8;
            const f32x4 g0 = *(const f32x4*)(g + c0), g1 = *(const f32x4*)(g + c0 + 4), b0 = *(const f32x4*)(b + c0), b1 = *(const f32x4*)(b + c0 + 4);
            f32x4 o0, o1;
#pragma unroll
            for (int e = 0; e < 4; ++e) { o0[e] = v[j * 8 + e] * rstd * g0[e] + b0[e]; o1[e] = v[j * 8 + 4 + e] * rstd * g1[e] + b1[e]; }
            if (out32) { *(f32x4*)(out32 + (size_t)row * DM + c0) = o0; *(f32x4*)(out32 + (size_t)row * DM + c0 + 4) = o1; }
            else *(u32x4*)(xr + c0) = pg8::pack8(o0, o1); }
    }
}


__device__ __forceinline__ void gla_prep(int wv, const Args& A, LAS unsigned char* lds, int G) {
    const int tid = opaque_tid(wv);
    unsigned char* ws = A.ws;
    const h16* PROJ = (const h16*)(ws + WS_HP);
    h16* QT = (h16*)(ws + WS_QT); h16* KT = (h16*)(ws + WS_KT); h16* KTT = (h16*)(ws + WS_KTT); h16* VT = (h16*)(ws + WS_VT);
    float* ER = (float*)(ws + WS_ER); float* DEC = (float*)(ws + WS_DEC); float* FF = (float*)(ws + WS_FF);
    LAS float* glr = (LAS float*)lds;
    LAS float* tot = glr + 1024;
    for (int u = blockIdx.x; u < 520 * 4; u += G) {
        const int cidx = u >> 2, h = u & 3; const size_t tok0 = (size_t)cidx * 64;
        const int k = tid & 127, tg = tid >> 7;
        h16 qv[16], kv[16], vv[32];
#pragma unroll
        for (int i = 0; i < 16; ++i) { const size_t pr = (tok0 + tg * 16 + i) * PW; qv[i] = PROJ[pr + C_GQ + h * 128 + k]; kv[i] = PROJ[pr + C_GK + h * 128 + k]; }
        { const int v = tid & 255, th = tid >> 8;
#pragma unroll
            for (int e = 0; e < 32; ++e) vv[e] = PROJ[(tok0 + th * 32 + e) * PW + C_GV + h * 256 + v]; }
        float w[16];
#pragma unroll
        for (int r = 0; r < 16; ++r) w[r] = A.in[16][r * 512 + h * 128 + k];
        const float ba = A.in[17][h * 128 + k];
        __syncthreads();
        if (tid < 128) { const int t = tid >> 1, hf = tid & 1; const h16x8 v = __builtin_bit_cast(h16x8, *(const u32x4*)(PROJ + (tok0 + t) * PW + C_GLR + hf * 8));
#pragma unroll
            for (int e = 0; e < 8; ++e) glr[t * 16 + hf * 8 + e] = (float)v[e]; }
        __syncthreads();
        float bl[16]; float run = 0.f;
#pragma unroll
        for (int i = 0; i < 16; ++i) { const int t = tg * 16 + i; float z = ba;
#pragma unroll
            for (int r = 0; r < 16; ++r) z += glr[t * 16 + r] * w[r];
            const float la = (fminf(z, 0.f) - __logf(1.f + __expf(-fabsf(z)))) * (1.f / 16.f); run += la; bl[i] = run; }
        tot[tg * 128 + k] = run;
        __syncthreads();
        const float t0 = tot[k], t1 = tot[128 + k], t2 = tot[256 + k], t3 = tot[384 + k];
        const float off = tg == 0 ? 0.f : tg == 1 ? t0 : tg == 2 ? t0 + t1 : t0 + t1 + t2;
        const float rr = t0 + t1, blast = (t0 + t1) + (t2 + t3);
        h16x8 kt8[2];
#pragma unroll
        for (int i = 0; i < 16; ++i) { const int t = tg * 16 + i; const float b = bl[i] + off;
            const float q = (float)qv[i], kk = (float)kv[i];
            const h16 qt = (h16)(q * __expf(b - rr)), ktv = (h16)(kk * __expf(rr - b));
            QT[(tok0 + t) * 512 + h * 128 + k] = qt; KT[(tok0 + t) * 512 + h * 128 + k] = ktv; kt8[i >> 3][i & 7] = (h16)(kk * __expf(blast - b)); }
        { h16* d = KTT + ((size_t)(cidx * 4 + h) * 128 + k) * 64 + tg * 16; *(u32x4*)d = __builtin_bit_cast(u32x4, kt8[0]); *(u32x4*)(d + 8) = __builtin_bit_cast(u32x4, kt8[1]); }
        if (tg == 0) { const int o = cidx * 512 + h * 128 + k; ER[o] = __expf(rr); DEC[o] = __expf(blast); FF[o] = __expf(blast - rr); }
        { const int v = tid & 255, th = tid >> 8;
#pragma unroll
            for (int c4 = 0; c4 < 4; ++c4) { h16x8 o;
#pragma unroll
                for (int e = 0; e < 8; ++e) o[e] = vv[c4 * 8 + e];
                *(u32x4*)(VT + ((size_t)(cidx * 4 + h) * 256 + v) * 64 + th * 32 + c4 * 8) = __builtin_bit_cast(u32x4, o); } }
    }
}

__device__ __forceinline__ u32x4 ldg16(const void* base, unsigned off) { return *(const u32x4*)((const char*)base + off); }
__device__ __forceinline__ void gla_chain(int wv, const Args& A, LAS unsigned char* lds, int cidx0, int nsteps, int h, int sl, const float* S0, float* Sout) {
    const int tid = opaque_tid(wv), lane = tid & 63, w = __builtin_amdgcn_readfirstlane(tid >> 6), fr = lane & 15, fq = lane >> 4;
    unsigned char* ws = A.ws;
    constexpr int BUFB = 54272;
    LAS unsigned char* STs = lds + 2 * BUFB;
    LAS unsigned char* As = lds + 2 * BUFB + 17408;
    const unsigned g_q = (unsigned)((tid >> 4) * 512 + (tid & 15) * 8) * 2u;
    const unsigned l_q = (unsigned)((tid >> 4) * 136 + (tid & 15) * 8) * 2u;
    const unsigned g_t = (unsigned)((tid >> 3) * 64 + (tid & 7) * 8) * 2u;
    const unsigned l_t = (unsigned)((tid >> 3) * 72 + (tid & 7) * 8) * 2u;
    const unsigned g_v = (unsigned)(fr * 64 + fq * 8) * 2u;
    const unsigned f136 = (unsigned)(fr * 136 + fq * 8) * 2u;
    const unsigned f72 = (unsigned)(fr * 72 + fq * 8) * 2u;
    const unsigned w136 = (unsigned)(fr * 136 + fq * 4) * 2u;
    const unsigned w72 = (unsigned)(fr * 72 + fq * 4) * 2u;
    const unsigned g_go = (unsigned)(fr * DM + fq * 4) * 2u;
    f32x4 Sacc[4];
#pragma unroll
    for (int vbl = 0; vbl < 4; ++vbl)
#pragma unroll
        for (int r = 0; r < 4; ++r) Sacc[vbl][r] = S0 ? *(const float*)((const char*)(S0 + (w * 16 + r) * 256 + sl * 64 + vbl * 16) + (unsigned)(fq * 4 * 256 + fr) * 4u) : 0.f;
    u32x4 rq[2], rk[2], rt[2]; float rs = 0.f; h16x8 vt[4][2], vo[2][2];
#define GLA_ISSUE(CIDX) do { const int c_ = (CIDX); const size_t t_ = (size_t)c_ * 64; \
        const char* uQ = (const char*)(ws + WS_QT) + (t_ * 512 + h * 128) * 2; const char* uK = (const char*)(ws + WS_KT) + (t_ * 512 + h * 128) * 2; \
        const char* uT = (const char*)(ws + WS_KTT) + (size_t)(c_ * 4 + h) * 128 * 64 * 2; const char* uV = (const char*)(ws + WS_VT) + ((size_t)(c_ * 4 + h) * 256 + sl * 64) * 64 * 2; \
        _Pragma("unroll") for (int i = 0; i < 2; ++i) { rq[i] = ldg16(uQ + i * 32 * 512 * 2, g_q); rk[i] = ldg16(uK + i * 32 * 512 * 2, g_q); rt[i] = ldg16(uT + i * 64 * 64 * 2, g_t); } \
        if (tid < 256) rs = ((const float*)(ws + (tid < 128 ? WS_ER : WS_DEC)))[c_ * 512 + h * 128 + (tid & 127)]; \
        _Pragma("unroll") for (int vbl = 0; vbl < 4; ++vbl) _Pragma("unroll") for (int ks = 0; ks < 2; ++ks) vt[vbl][ks] = __builtin_bit_cast(h16x8, ldg16(uV + (vbl * 16 * 64 + ks * 32) * 2, g_v)); \
        _Pragma("unroll") for (int j = 0; j < 2; ++j) _Pragma("unroll") for (int ks = 0; ks < 2; ++ks) vo[j][ks] = __builtin_bit_cast(h16x8, ldg16(uV + (((w & 1) * 2 + j) * 16 * 64 + ks * 32) * 2, g_v)); } while (0)
    GLA_ISSUE(cidx0);
    for (int step = 0; step < nsteps; ++step) {
        const int cidx = cidx0 + step; const size_t tok0 = (size_t)cidx * 64;
        LAS unsigned char* buf = lds + (step & 1) * BUFB;
        LAS unsigned char* QTs = buf; LAS unsigned char* KTs = buf + 17408; LAS unsigned char* KTTs = buf + 34816; LAS float* scal = (LAS float*)(buf + 53248);
#pragma unroll
        for (int i = 0; i < 2; ++i) { *(LAS u32x4*)(QTs + l_q + i * 32 * 136 * 2) = rq[i]; *(LAS u32x4*)(KTs + l_q + i * 32 * 136 * 2) = rk[i]; *(LAS u32x4*)(KTTs + l_t + i * 64 * 72 * 2) = rt[i]; }
        if (tid < 256) scal[tid] = rs;
        h16x8 vc[4][2];
#pragma unroll
        for (int vbl = 0; vbl < 4; ++vbl)
#pragma unroll
            for (int ks = 0; ks < 2; ++ks) vc[vbl][ks] = vt[vbl][ks];
        h16x8 voc[2][2];
#pragma unroll
        for (int j = 0; j < 2; ++j) { voc[j][0] = vo[j][0]; voc[j][1] = vo[j][1]; }
        if (step + 1 < nsteps) GLA_ISSUE(cidx + 1);
        __syncthreads();
#pragma unroll
        for (int vbl = 0; vbl < 4; ++vbl) { h16x4 s4;
#pragma unroll
            for (int r = 0; r < 4; ++r) s4[r] = (h16)(Sacc[vbl][r] * scal[w * 16 + fq * 4 + r]);
            *(LAS u32x2*)(STs + w136 + (vbl * 16 * 136 + w * 16) * 2) = __builtin_bit_cast(u32x2, s4); }
#pragma unroll
        for (int tt = 0; tt < 2; ++tt) { const int t = 2 * w + tt, ib = t >> 2, jb = t & 3; f32x4 a = {0.f, 0.f, 0.f, 0.f};
            if (jb <= ib) {
#pragma unroll
                for (int ks = 0; ks < 4; ++ks) { const h16x8 kf = *(const LAS h16x8*)(KTs + f136 + (jb * 16 * 136 + ks * 32) * 2), qf = *(const LAS h16x8*)(QTs + f136 + (ib * 16 * 136 + ks * 32) * 2);
                    a = __builtin_amdgcn_mfma_f32_16x16x32_f16(kf, qf, a, 0, 0, 0); }
#pragma unroll
                for (int r = 0; r < 4; ++r) if (jb * 16 + fq * 4 + r > ib * 16 + fr) a[r] = 0.f;
            }
            h16x4 a4; a4[0] = (h16)a[0]; a4[1] = (h16)a[1]; a4[2] = (h16)a[2]; a4[3] = (h16)a[3];
            *(LAS u32x2*)(As + w72 + (ib * 16 * 72 + jb * 16) * 2) = __builtin_bit_cast(u32x2, a4); }
        __syncthreads();
        { const int ib = w >> 1;
#pragma unroll
            for (int j = 0; j < 2; ++j) { const int vbl = (w & 1) * 2 + j; f32x4 o = {0.f, 0.f, 0.f, 0.f};
#pragma unroll
                for (int ks = 0; ks < 4; ++ks) { const h16x8 sf = *(const LAS h16x8*)(STs + f136 + (vbl * 16 * 136 + ks * 32) * 2), qf = *(const LAS h16x8*)(QTs + f136 + (ib * 16 * 136 + ks * 32) * 2);
                    o = __builtin_amdgcn_mfma_f32_16x16x32_f16(sf, qf, o, 0, 0, 0); }
#pragma unroll
                for (int ks = 0; ks < 2; ++ks) { const h16x8 af = *(const LAS h16x8*)(As + f72 + (ib * 16 * 72 + ks * 32) * 2);
                    o = __builtin_amdgcn_mfma_f32_16x16x32_f16(voc[j][ks], af, o, 0, 0, 0); }
                h16x4 o4; o4[0] = (h16)o[0]; o4[1] = (h16)o[1]; o4[2] = (h16)o[2]; o4[3] = (h16)o[3];
                *(u32x2*)((char*)(ws + WS_MIX) + ((tok0 + ib * 16) * DM + 1024 + h * 256 + sl * 64 + vbl * 16) * 2 + g_go) = __builtin_bit_cast(u32x2, o4); } }
#pragma unroll
        for (int vbl = 0; vbl < 4; ++vbl) {
#pragma unroll
            for (int r = 0; r < 4; ++r) Sacc[vbl][r] *= scal[128 + w * 16 + fq * 4 + r];
#pragma unroll
            for (int ks = 0; ks < 2; ++ks) { const h16x8 kf = *(const LAS h16x8*)(KTTs + f72 + (w * 16 * 72 + ks * 32) * 2);
                Sacc[vbl] = __builtin_amdgcn_mfma_f32_16x16x32_f16(kf, vc[vbl][ks], Sacc[vbl], 0, 0, 0); } }
    }
#undef GLA_ISSUE
#pragma unroll
    for (int vbl = 0; vbl < 4; ++vbl)
#pragma unroll
        for (int r = 0; r < 4; ++r) *(float*)((char*)(Sout + (w * 16 + r) * 256 + sl * 64 + vbl * 16) + (unsigned)(fq * 4 * 256 + fr) * 4u) = Sacc[vbl][r];
    __syncthreads();
}
__device__ __forceinline__ void gla_out_phase(int wv, const Args& A, int G) {
    const int tid = opaque_tid(wv), lane = tid & 63, w = tid >> 6;
    unsigned char* ws = A.ws;
    const h16* PROJ = (const h16*)(ws + WS_HP); h16* MIX = (h16*)(ws + WS_MIX);
    for (int row0 = (blockIdx.x * 8 + w) * 2; row0 < MT * 4; row0 += G * 16) {
        h16x4 o4[2], gr[2]; f32x4 gn[2];
#pragma unroll
        for (int u = 0; u < 2; ++u) { const int row = row0 + u; const size_t tok = (size_t)(row >> 2); const int h = row & 3;
            o4[u] = __builtin_bit_cast(h16x4, *(const u32x2*)(MIX + tok * DM + 1024 + h * 256 + lane * 4));
            gr[u] = __builtin_bit_cast(h16x4, *(const u32x2*)(PROJ + tok * PW + C_GR + h * 256 + lane * 4));
            gn[u] = *(const f32x4*)(A.in[18] + h * 256 + lane * 4); }
#pragma unroll
        for (int u = 0; u < 2; ++u) { const int row = row0 + u; const size_t tok = (size_t)(row >> 2); const int h = row & 3;
            float x[4]; float s = 0.f;
#pragma unroll
            for (int r = 0; r < 4; ++r) { x[r] = (float)o4[u][r]; s += x[r]; }
            const float mean = wave_sum(s) * (1.f / 256.f); float q = 0.f;
#pragma unroll
            for (int r = 0; r < 4; ++r) { x[r] -= mean; q += x[r] * x[r]; }
            const float rstd = 1.f / sqrtf(wave_sum(q) * (1.f / 256.f) + LN_EPS); h16x4 y;
#pragma unroll
            for (int r = 0; r < 4; ++r) { const float g = (float)gr[u][r]; y[r] = (h16)(x[r] * rstd * gn[u][r] * (g * __builtin_amdgcn_rcpf(1.f + __expf(-g)))); }
            *(u32x2*)(MIX + tok * DM + 1024 + h * 256 + lane * 4) = __builtin_bit_cast(u32x2, y); }
    }
}

constexpr int CAP = 1216;
__device__ __forceinline__ const h16* key_row(const unsigned char* ws, int s, int j, int ccol, size_t cache_off, int cw) {
    const h16* tab = (ccol == C_KI) ? (const h16*)(ws + WS_KIC) : (const h16*)(ws + WS_KVC) + (ccol == C_V ? 256 : 0);
    const int stride = (ccol == C_KI) ? 64 : 512;
    if (s < 2) return tab + ((size_t)s * SEQ + j) * stride;
    const int bs = s - 2;
    if (j < PAST) return (const h16*)(ws + cache_off) + ((size_t)bs * PAST + j) * cw;
    return tab + ((size_t)NP + bs * 64 + (j - PAST)) * stride;
}
__device__ __forceinline__ unsigned f2ord(float f) { const unsigned u = __builtin_bit_cast(unsigned, f); return u ^ ((u >> 31) ? 0xFFFFFFFFu : 0x80000000u); }
__device__ __forceinline__ float ord2f(unsigned x) { const unsigned u = (x >> 31) ? (x ^ 0x80000000u) : ~x; return __builtin_bit_cast(float, u); }
template <bool FINAL>
__device__ __forceinline__ void dsa_prune(LAS unsigned* cs, LAS unsigned short* ci, LAS unsigned* cnt, LAS float* thr, int q, int lane) {
    const int n = __builtin_amdgcn_readfirstlane((int)cnt[q]);
    if (n <= 256) return;
    LAS unsigned* c = cs + q * CAP; LAS unsigned short* ix = ci + q * CAP;
    constexpr int NE = CAP / 64;
    unsigned x[NE];
#pragma unroll
    for (int i = 0; i < NE; ++i) { const int e = i * 64 + lane; x[i] = e < n ? c[e] : 0u; }
    unsigned prefix = 0u; int kp = n;
    for (int bit = 31; bit >= 0; --bit) { const unsigned trial = prefix | (1u << bit); int k = 0;
#pragma unroll
        for (int i = 0; i < NE; ++i) k += __popcll(__ballot(x[i] >= trial));
        if (k >= 256) { prefix = trial; kp = k; }
        if (kp == 256 || (!FINAL && bit <= 16 && kp <= 320)) break; }
    int base = 0;
#pragma unroll
    for (int i = 0; i < NE; ++i) { const int e = i * 64 + lane; const unsigned short id = e < n ? ix[e] : (unsigned short)0;
        const bool keep = x[i] >= prefix; const unsigned long long mask = __ballot(keep);
        const int pos = base + (int)__builtin_amdgcn_mbcnt_hi((unsigned)(mask >> 32), __builtin_amdgcn_mbcnt_lo((unsigned)mask, 0u));
        LDS_WAIT();
        if (keep) { c[pos] = x[i]; ix[pos] = id; }
        base += __popcll(mask); }
    if (lane == 0) { cnt[q] = (unsigned)base; thr[q] = ord2f(prefix); }
}
__device__ __forceinline__ int rel_bucket(int rel) {
    const int n = rel < 0 ? -rel : rel;
    const int b = n < 8 ? n : 8 + (n >= 12) + (n >= 16) + (n >= 23) + (n >= 32) + (n >= 46) + (n >= 64) + (n >= 91);
    return b + (rel > 0 ? 16 : 0);
}
__device__ __forceinline__ void dsa_unit(int wv, const Args& A, LAS unsigned char* lds, int s, int qt) {
    const int tid = opaque_tid(wv), lane = tid & 63, w = __builtin_amdgcn_readfirstlane(tid >> 6), fr = lane & 15, fq = lane >> 4;
    const unsigned char* ws = A.ws;
    const h16* PROJ = (const h16*)(ws + WS_HP); h16* MIX = (h16*)(A.ws + WS_MIX);
    const bool prompt = s < 2; const int bs = s - 2;
    const int L = prompt ? 64 * ((qt >> 2) + 1) : (PAST + 64);
    const size_t qrow0 = prompt ? (size_t)s * SEQ + qt * 16 : (size_t)NP + bs * 64 + qt * 16;
    const int qpos0 = prompt ? qt * 16 : PAST + qt * 16;
    LAS unsigned* cs = (LAS unsigned*)lds;
    LAS unsigned short* ci = (LAS unsigned short*)(lds + 77824);
    LAS unsigned* cnt = (LAS unsigned*)(lds + 116736);
    LAS float* thr = (LAS float*)(lds + 116800);
    LAS float* relb = (LAS float*)(lds + 116864);
    LAS h16* Pw = (LAS h16*)(lds + 117888 + w * 4096);
    LAS float* wql = (LAS float*)(lds + 152704);
    if (tid < 16) { cnt[tid] = 0u; thr[tid] = -INFINITY; }
    if (tid < 256) relb[tid] = A.in[9][tid];
    LAS u32x4* Ql = (LAS u32x4*)(lds + 117888);
    const h16* qp = PROJ + (qrow0 + fr) * PW;
    float wq[16];
    { const h16x8 w0 = __builtin_bit_cast(h16x8, *(const u32x4*)(qp + C_WI)), w1 = __builtin_bit_cast(h16x8, *(const u32x4*)(qp + C_WI + 8));
#pragma unroll
        for (int e = 0; e < 8; ++e) { wq[e] = (float)w0[e]; wq[8 + e] = (float)w1[e]; } }
#pragma unroll
    for (int i = 0; i < 4; ++i) { const int c = tid + i * 512; const int hh = c >> 7, ks = (c >> 6) & 1, ln = c & 63;
        Ql[c] = *(const u32x4*)(PROJ + (qrow0 + (ln & 15)) * PW + C_QI + hh * 64 + ks * 32 + (ln >> 4) * 8); }
    if (w == 2 && fq == 0) {
#pragma unroll
        for (int hh = 0; hh < 16; ++hh) wql[hh * 16 + fr] = wq[hh]; }
    if (w < 2) { float lin[8];
#pragma unroll
        for (int e = 0; e < 8; ++e) lin[e] = 0.f;
#pragma unroll
        for (int hh = 0; hh < 16; ++hh) { const h16x8 qv = __builtin_bit_cast(h16x8, *(const u32x4*)(qp + C_QI + hh * 64 + w * 32 + fq * 8));
#pragma unroll
            for (int e = 0; e < 8; ++e) lin[e] += wq[hh] * (float)qv[e]; }
        h16x8 lh;
#pragma unroll
        for (int e = 0; e < 8; ++e) lh[e] = (h16)lin[e];
        Ql[(32 + w) * 64 + lane] = __builtin_bit_cast(u32x4, lh); }
    __syncthreads();
    float th = -INFINITY;
    const int ntiles = L >> 4;
    h16x8 nK[4][2];
#define DSA_LOADK(KT) do { const int kt_ = (KT); if (kt_ < ntiles) { _Pragma("unroll") for (int t_ = 0; t_ < 4; ++t_) { const h16* p_ = key_row(ws, s, (kt_ + t_) * 16 + fr, C_KI, WS_CKI, 64); \
        nK[t_][0] = __builtin_bit_cast(h16x8, *(const u32x4*)(p_ + fq * 8)); nK[t_][1] = __builtin_bit_cast(h16x8, *(const u32x4*)(p_ + 32 + fq * 8)); } } } while (0)
#pragma unroll
    for (int t = 0; t < 4; ++t) { nK[t][0] = (h16x8){0, 0, 0, 0, 0, 0, 0, 0}; nK[t][1] = (h16x8){0, 0, 0, 0, 0, 0, 0, 0}; }
    DSA_LOADK(4 * w);
    for (int kt0 = 0; kt0 < ntiles; kt0 += 32) {
        const int kt = kt0 + 4 * w;
        h16x8 kc[4][2];
#pragma unroll
        for (int t = 0; t < 4; ++t) { kc[t][0] = nK[t][0]; kc[t][1] = nK[t][1]; }
        DSA_LOADK(kt + 32);
        if (kt < ntiles) {
            f32x4 sc[4];
#pragma unroll
            for (int t = 0; t < 4; ++t) sc[t] = (f32x4){0.f, 0.f, 0.f, 0.f};
#pragma unroll 2
            for (int hh = 0; hh < 16; ++hh) {
                const h16x8 q0 = __builtin_bit_cast(h16x8, Ql[(hh * 2) * 64 + lane]), q1 = __builtin_bit_cast(h16x8, Ql[(hh * 2 + 1) * 64 + lane]);
                const float wh = wql[hh * 16 + fr];
                f32x4 a[4];
#pragma unroll
                for (int t = 0; t < 4; ++t) a[t] = __builtin_amdgcn_mfma_f32_16x16x32_f16(kc[t][0], q0, (f32x4){0.f, 0.f, 0.f, 0.f}, 0, 0, 0);
#pragma unroll
                for (int t = 0; t < 4; ++t) a[t] = __builtin_amdgcn_mfma_f32_16x16x32_f16(kc[t][1], q1, a[t], 0, 0, 0);
#pragma unroll
                for (int t = 0; t < 4; ++t)
#pragma unroll
                    for (int r = 0; r < 4; ++r) sc[t][r] += wh * fabsf(a[t][r]);
            }
            { const h16x8 q0 = __builtin_bit_cast(h16x8, Ql[32 * 64 + lane]), q1 = __builtin_bit_cast(h16x8, Ql[33 * 64 + lane]);
#pragma unroll
                for (int t = 0; t < 4; ++t) { sc[t] = __builtin_amdgcn_mfma_f32_16x16x32_f16(kc[t][0], q0, sc[t], 0, 0, 0); sc[t] = __builtin_amdgcn_mfma_f32_16x16x32_f16(kc[t][1], q1, sc[t], 0, 0, 0); } }
            int c = 0;
#pragma unroll
            for (int t = 0; t < 4; ++t)
#pragma unroll
                for (int r = 0; r < 4; ++r) c += (sc[t][r] > th) ? 1 : 0;
            if (c) { unsigned pos = __hip_atomic_fetch_add((unsigned*)(cnt + fr), (unsigned)c, __ATOMIC_RELAXED, __HIP_MEMORY_SCOPE_WORKGROUP);
#pragma unroll
                for (int t = 0; t < 4; ++t)
#pragma unroll
                    for (int r = 0; r < 4; ++r) if (sc[t][r] > th) { if (pos < (unsigned)CAP) { cs[fr * CAP + pos] = f2ord(sc[t][r]); ci[fr * CAP + pos] = (unsigned short)((kt + t) * 16 + fq * 4 + r); } ++pos; } }
        }
        __syncthreads();
        const bool need = __ballot(cnt[fr] > (unsigned)(CAP - 512)) != 0ull;
        if (need) { dsa_prune<false>(cs, ci, cnt, thr, 2 * w, lane); dsa_prune<false>(cs, ci, cnt, thr, 2 * w + 1, lane); }
        __syncthreads();
        if (need) th = thr[fr];
    }
#undef DSA_LOADK
    if (lane < 2) { if (cnt[2 * w + lane] > (unsigned)CAP) cnt[2 * w + lane] = (unsigned)CAP; }
    dsa_prune<true>(cs, ci, cnt, thr, 2 * w, lane); dsa_prune<true>(cs, ci, cnt, thr, 2 * w + 1, lane);
    for (int qi2 = 0; qi2 < 2; ++qi2) {
        const int qq = 2 * w + qi2; int n = __builtin_amdgcn_readfirstlane((int)cnt[qq]); n = n > 256 ? 256 : n;
        const size_t qrow = qrow0 + qq; const int qpos = qpos0 + qq;
        LAS const unsigned short* lst = ci + qq * CAP;
        long qf[8];
#pragma unroll
        for (int kk = 0; kk < 8; ++kk) { qf[kk] = 0;
            if (fr < 8 && (fr >> 2) == (kk >> 2)) { const h16x8 q = __builtin_bit_cast(h16x8, *(const u32x4*)(PROJ + qrow * PW + C_Q + fr * 128 + ((kk >> 1) & 1) * 64 + fq * 16 + (kk & 1) * 8));
                f32x4 a, bq;
#pragma unroll
                for (int e = 0; e < 4; ++e) { a[e] = 16.f * (float)q[e]; bq[e] = 16.f * (float)q[4 + e]; }
                qf[kk] = __builtin_bit_cast(long, pack_fp8x8(a, bq)); } }
        const int nt = n >> 4;
        long kf[8];
#define DSA_LOADT(DST, T) do { const int t_ = (T) < nt ? (T) : nt - 1; const int j_ = lst[t_ * 16 + fr]; \
        const unsigned char* kp_ = (s < 2) ? ws + WS_KC8 + ((size_t)s * SEQ + j_) * 256 : (j_ < PAST ? ws + WS_CK8 + ((size_t)(s - 2) * PAST + j_) * 256 : ws + WS_KC8 + ((size_t)NP + (s - 2) * 64 + (j_ - PAST)) * 256); \
        _Pragma("unroll") for (int k2 = 0; k2 < 4; ++k2) { const u32x4 w_ = *(const u32x4*)(kp_ + k2 * 64 + fq * 16); u32x2 lo_, hi_; lo_[0] = w_[0]; lo_[1] = w_[1]; hi_[0] = w_[2]; hi_[1] = w_[3]; \
            DST[2 * k2] = __builtin_bit_cast(long, lo_); DST[2 * k2 + 1] = __builtin_bit_cast(long, hi_); } } while (0)
        DSA_LOADT(kf, 0);
        for (int kt = 0; kt < nt; ++kt) {
            long k1[8];
            DSA_LOADT(k1, kt + 1);
            f32x4 a = {0.f, 0.f, 0.f, 0.f};
#pragma unroll
            for (int kk = 0; kk < 8; ++kk) a = __builtin_amdgcn_mfma_f32_16x16x32_fp8_fp8(kf[kk], qf[kk], a, 0, 0, 0);
            if (fr < 8) {
#pragma unroll
                for (int r = 0; r < 4; ++r) { const int e2 = kt * 16 + fq * 4 + r; const int key2 = lst[e2];
                    Pw[e2 * 8 + fr] = (h16)(a[r] * 0.0625f + relb[rel_bucket(key2 - qpos) * 8 + fr]); } }
#pragma unroll
            for (int kk = 0; kk < 8; ++kk) kf[kk] = k1[kk];
        }
#undef DSA_LOADT
        { float v[4][8]; float m[8];
#pragma unroll
            for (int hh = 0; hh < 8; ++hh) m[hh] = -INFINITY;
#pragma unroll
            for (int i = 0; i < 4; ++i) { const int e = lane * 4 + i; const h16x8 hv = e < n ? *(const LAS h16x8*)(Pw + e * 8) : (h16x8){0, 0, 0, 0, 0, 0, 0, 0};
#pragma unroll
                for (int j = 0; j < 8; ++j) { v[i][j] = e < n ? (float)hv[j] : -INFINITY; m[j] = fmaxf(m[j], v[i][j]); } }
            float sm[8];
#pragma unroll
            for (int hh = 0; hh < 8; ++hh) { m[hh] = wave_max(m[hh]); sm[hh] = 0.f; }
#pragma unroll
            for (int i = 0; i < 4; ++i)
#pragma unroll
                for (int j = 0; j < 8; ++j) { const float p = __expf(v[i][j] - m[j]); v[i][j] = p; sm[j] += p; }
#pragma unroll
            for (int hh = 0; hh < 8; ++hh) sm[hh] = 1.f / wave_sum(sm[hh]);
#pragma unroll
            for (int i = 0; i < 4; ++i) { const int e = lane * 4 + i;
                if (e < n) { h16x8 o;
#pragma unroll
                    for (int j = 0; j < 8; ++j) o[j] = (h16)(v[i][j] * sm[j]);
                    *(LAS h16x8*)(Pw + e * 8) = o; } } }
        { const int ksub = lane >> 4, sl16 = lane & 15, g = sl16 >> 3;
            float acc[4][16];
#pragma unroll
            for (int hh = 0; hh < 4; ++hh)
#pragma unroll
                for (int d = 0; d < 16; ++d) acc[hh][d] = 0.f;
            for (int eb = 0; eb < n; eb += 64) {
                h16x2 a2[4][8];
#pragma unroll
                for (int hh = 0; hh < 4; ++hh)
#pragma unroll
                    for (int d2 = 0; d2 < 8; ++d2) a2[hh][d2] = (h16x2){0, 0};
#pragma unroll
                for (int e0 = 0; e0 < 64; e0 += 4) { const int e = eb + e0 + ksub; const int j_ = lst[e];
                    const unsigned char* vp = (s < 2) ? ws + WS_VC8 + ((size_t)s * SEQ + j_) * 256 : (j_ < PAST ? ws + WS_CV8 + ((size_t)(s - 2) * PAST + j_) * 256 : ws + WS_VC8 + ((size_t)NP + (s - 2) * 64 + (j_ - PAST)) * 256);
                    const u32x4 wv8 = *(const u32x4*)(vp + sl16 * 16);
                    const h16x4 ph = *(const LAS h16x4*)(Pw + e * 8 + g * 4);
                    h16x2 v2[8];
#pragma unroll
                    for (int d2 = 0; d2 < 8; ++d2) { const f32x2 f2 = (d2 & 1) ? __builtin_amdgcn_cvt_pk_f32_fp8((int)wv8[d2 >> 1], true) : __builtin_amdgcn_cvt_pk_f32_fp8((int)wv8[d2 >> 1], false);
                        v2[d2] = (h16x2){(h16)f2[0], (h16)f2[1]}; }
#pragma unroll
                    for (int hh = 0; hh < 4; ++hh) { const h16x2 pp = {ph[hh], ph[hh]};
#pragma unroll
                        for (int d2 = 0; d2 < 8; ++d2) a2[hh][d2] = __builtin_elementwise_fma(pp, v2[d2], a2[hh][d2]); } }
#pragma unroll
                for (int hh = 0; hh < 4; ++hh)
#pragma unroll
                    for (int d2 = 0; d2 < 8; ++d2) { acc[hh][2 * d2] += (float)a2[hh][d2][0]; acc[hh][2 * d2 + 1] += (float)a2[hh][d2][1]; }
            }
#pragma unroll
            for (int hh = 0; hh < 4; ++hh) { h16x8 o8a, o8b;
#pragma unroll
                for (int d = 0; d < 16; ++d) { float t = acc[hh][d] + __shfl_xor(acc[hh][d], 16); t += __shfl_xor(t, 32); if (d < 8) o8a[d] = (h16)t; else o8b[d - 8] = (h16)t; }
                if (ksub == 0) { h16* op = MIX + qrow * DM + (g * 4 + hh) * 128 + (sl16 & 7) * 16; *(u32x4*)op = __builtin_bit_cast(u32x4, o8a); *(u32x4*)(op + 8) = __builtin_bit_cast(u32x4, o8b); } } }
    }
    __syncthreads();
}

__device__ __forceinline__ void mixer_phase(int wv, const Args& A, LAS unsigned char* lds) {
    LAS int* itemw = (LAS int*)(lds + LDS_BYTES - 64);
    unsigned* ctr = (unsigned*)(A.ws + WS_CTL);
    constexpr int N_GP = 32, N_DP = 2048, N_DS = 32, N_GS = 128, NIT = N_GP + N_DP + N_DS + N_GS;
    for (;;) {
        __syncthreads();
        if (opaque_tid(wv) == 0) *itemw = (int)atomicAdd(ctr, 1u);
        __syncthreads();
        int it = *itemw;
        if (it >= NIT) break;
        if (it < N_GP) { const int b = it >> 4, h = (it >> 2) & 3, sl = it & 3; gla_chain(wv, A, lds, b * 256, 256, h, sl, nullptr, A.out + O_SP + (size_t)(b * 4 + h) * 32768); continue; }
        it -= N_GP;
        if (it < N_DP) { dsa_unit(wv, A, lds, it & 1, 1023 - (it >> 1)); continue; }
        it -= N_DP;
        if (it < N_DS) { dsa_unit(wv, A, lds, 2 + (it >> 2), it & 3); continue; }
        it -= N_DS;
        { const int bs = it >> 4, h = (it >> 2) & 3, sl = it & 3; gla_chain(wv, A, lds, 512 + bs, 1, h, sl, A.in[5] + (size_t)(bs * 4 + h) * 32768, A.out + O_SS + (size_t)(bs * 4 + h) * 32768); }
    }
}

__device__ __forceinline__ void mem_attn_phase(int wv, const Args& A, LAS unsigned char* lds, int G) {
    const int tid = opaque_tid(wv), lane = tid & 63, w = tid >> 6, fr = lane & 15, fq = lane >> 4;
    unsigned char* ws = A.ws;
    const h16* MQ = (const h16*)(ws + WS_MQ); h16* MO = (h16*)(ws + WS_MO);
    LAS h16* Pw = (LAS h16*)(lds + w * 8448);
    for (int wu = blockIdx.x * 8 + w; wu < (MT / 16) * 4; wu += G * 8) {
        const int blk = wu >> 3; const int h = blk & 3, tile = (blk >> 2) * 8 + (wu & 7); const size_t row0 = (size_t)tile * 16;
        const h16* Kb; const h16* VTb;
        if (row0 < NP) { const int b = (int)(row0 >> 14); Kb = (const h16*)(ws + WS_MK16) + (size_t)b * 256 * 512; VTb = (const h16*)(ws + WS_MVT) + (size_t)(b * 4 + h) * 32768; }
        else { const int bs = (int)((row0 - NP) >> 6); Kb = (const h16*)(ws + WS_CMK) + (size_t)bs * 256 * 512; VTb = (const h16*)(ws + WS_CMVT) + (size_t)(bs * 4 + h) * 32768; }
        h16x8 qf[4];
#pragma unroll
        for (int ks = 0; ks < 4; ++ks) qf[ks] = __builtin_bit_cast(h16x8, *(const u32x4*)(MQ + (row0 + fr) * 512 + h * 128 + ks * 32 + fq * 8));
        f32x4 lg[16]; float m = -INFINITY;
#pragma unroll
        for (int kt = 0; kt < 16; ++kt) { f32x4 a = {0.f, 0.f, 0.f, 0.f};
#pragma unroll
            for (int ks = 0; ks < 4; ++ks) { const h16x8 kf = __builtin_bit_cast(h16x8, *(const u32x4*)(Kb + (size_t)(kt * 16 + fr) * 512 + h * 128 + ks * 32 + fq * 8)); a = __builtin_amdgcn_mfma_f32_16x16x32_f16(kf, qf[ks], a, 0, 0, 0); }
            lg[kt] = a; m = fmaxf(m, fmaxf(fmaxf(a[0], a[1]), fmaxf(a[2], a[3]))); }
        m = fmaxf(m, __shfl_xor(m, 16)); m = fmaxf(m, __shfl_xor(m, 32));
        float sm = 0.f;
#pragma unroll
        for (int kt = 0; kt < 16; ++kt) { h16x4 p4;
#pragma unroll
            for (int r = 0; r < 4; ++r) { const float p = __expf(lg[kt][r] - m); sm += p; p4[r] = (h16)p; }
            *(LAS u32x2*)(Pw + fr * 264 + kt * 16 + fq * 4) = __builtin_bit_cast(u32x2, p4); }
        sm += __shfl_xor(sm, 16); sm += __shfl_xor(sm, 32);
        const float inv = 1.f / sm;
#pragma unroll
        for (int db = 0; db < 8; ++db) { f32x4 o = {0.f, 0.f, 0.f, 0.f};
#pragma unroll
            for (int ks = 0; ks < 8; ++ks) { const h16x8 vf = __builtin_bit_cast(h16x8, *(const u32x4*)(VTb + (size_t)(db * 16 + fr) * 256 + ks * 32 + fq * 8));
                const h16x8 pf = *(const LAS h16x8*)(Pw + fr * 264 + ks * 32 + fq * 8); o = __builtin_amdgcn_mfma_f32_16x16x32_f16(vf, pf, o, 0, 0, 0); }
            h16x4 o4; o4[0] = (h16)(o[0] * inv); o4[1] = (h16)(o[1] * inv); o4[2] = (h16)(o[2] * inv); o4[3] = (h16)(o[3] * inv);
            *(u32x2*)(MO + (row0 + fr) * 512 + h * 128 + db * 16 + fq * 4) = __builtin_bit_cast(u32x2, o4); }
    }
}

#define XB_TMO      128
#define XB_XCNT(j)  (256  + 64 * (j))
#define XB_XSUB(j)  (1280 + 64 * (j))
#define XB_XGEN(j)  (2304 + 64 * (j))
#define XB_TOP      3328
#define XB_TOPGEN   3392
#define XCD_BAR_WORDS 3456
#define XB_SPIN_CAP (1u << 18)

__device__ __forceinline__ unsigned xb_ld(unsigned* p)              { return __hip_atomic_load(p, __ATOMIC_RELAXED, __HIP_MEMORY_SCOPE_AGENT); }
__device__ __forceinline__ unsigned xb_add(unsigned* p, unsigned v) { return __hip_atomic_fetch_add(p, v, __ATOMIC_RELAXED, __HIP_MEMORY_SCOPE_AGENT); }
__device__ __forceinline__ unsigned xb_xcc_id() { return (unsigned)__builtin_amdgcn_s_getreg((3 << 11) | 20) & 0xFu; }
#define XB_SPIN(cond, bar) do { unsigned _sp = 0; while (cond) { __builtin_amdgcn_s_sleep(1); \
    if ((++_sp & 255u) == 0u) { if (xb_ld(&(bar)[XB_TMO])) break; if (_sp > XB_SPIN_CAP) { atomicAdd(&(bar)[XB_TMO], 1u); break; } } } } while (0)

struct XcdBarrier {
    unsigned* bar; unsigned x;
    volatile LAS unsigned* st;
};

__device__ __forceinline__ XcdBarrier xcd_barrier_post(unsigned* bar, volatile LAS unsigned* st) {
    XcdBarrier b; b.bar = bar; b.x = xb_xcc_id(); b.st = st;
    if (threadIdx.x == 0) (void)xb_add(&bar[XB_XCNT(b.x)], 1u);
    return b;
}
__device__ __forceinline__ void xcd_barrier_complete(unsigned* bar, unsigned x, unsigned& nloc, unsigned& nx) {
    const unsigned G = gridDim.x * gridDim.y * gridDim.z;
    unsigned sum, cnt, mine, sp = 0u;
    for (;;) {
        sum = 0u; cnt = 0u; mine = 0u;
#pragma unroll
        for (unsigned j = 0; j < 16; ++j) { const unsigned c = xb_ld(&bar[XB_XCNT(j)]); sum += c; cnt += (c > 0u) ? 1u : 0u; mine = (j == x) ? c : mine; }
        if (sum == G) break;
        __builtin_amdgcn_s_sleep(1);
        if ((++sp & 255u) == 0u) { if (xb_ld(&bar[XB_TMO])) break; if (sp > XB_SPIN_CAP) { atomicAdd(&bar[XB_TMO], 1u); break; } }
    }
    nloc = mine > 0u ? mine : 1u; nx = cnt > 0u ? cnt : 1u;
}

__device__ __forceinline__ void xcd_barrier(const XcdBarrier& b) {
    asm volatile("s_waitcnt vmcnt(0)" ::: "memory");
    __syncthreads();
    if (threadIdx.x == 0) {
        unsigned* bar = b.bar;
        __builtin_amdgcn_s_waitcnt(0);
        unsigned nloc = b.st[0], nx = b.st[1];
        if (nloc == 0u) { xcd_barrier_complete(bar, b.x, nloc, nx); b.st[0] = nloc; b.st[1] = nx; }
        const unsigned old = xb_add(&bar[XB_XSUB(b.x)], 1u);
        const unsigned gen = old / nloc;
        if (old + 1u == (gen + 1u) * nloc) {
            __builtin_amdgcn_fence(__ATOMIC_RELEASE, "agent");
            asm volatile("s_waitcnt vmcnt(0)" ::: "memory");
            const unsigned og = xb_add(&bar[XB_TOP], 1u);
            const unsigned tg = og / nx;
            if (og + 1u == (tg + 1u) * nx) xb_add(&bar[XB_TOPGEN], 1u);
            else XB_SPIN(xb_ld(&bar[XB_TOPGEN]) == tg, bar);
            __builtin_amdgcn_fence(__ATOMIC_ACQUIRE, "agent");
            xb_add(&bar[XB_XGEN(b.x)], 1u);
            asm volatile("s_waitcnt vmcnt(0)" ::: "memory");
        } else {
            XB_SPIN(xb_ld(&bar[XB_XGEN(b.x)]) == gen, bar);
            __builtin_amdgcn_fence(__ATOMIC_ACQUIRE, "agent");
            asm volatile("s_waitcnt vmcnt(0)" ::: "memory");
        }
    }
    __syncthreads();
}

__global__ void __launch_bounds__(512, 2) fwd_mega(Args A) {
    extern __shared__ __attribute__((aligned(16))) unsigned char lds_raw[];
    LAS unsigned char* lds = (LAS unsigned char*)lds_raw;
    cg::grid_group grid = cg::this_grid();
    const int wv = __builtin_amdgcn_readfirstlane((int)threadIdx.x >> 6);
    const int G = gridDim.x;
    unsigned char* ws = A.ws;
    h16* X = (h16*)(ws + WS_X); h16* HP = (h16*)(ws + WS_HP);
    pg8::StaticOrder S; pg8::SplitTailOrder ST;
    volatile LAS unsigned* bst = (volatile LAS unsigned*)(lds + LDS_BYTES - 32);
    if (threadIdx.x == 0) { bst[0] = 0u; bst[1] = 0u; }
    __syncthreads();
    if (blockIdx.x == 0) { for (int i = threadIdx.x; i < 4096; i += 512) ((unsigned*)(ws + WS_BAR))[i] = 0u; }
    float* PART = (float*)(ws + WS_PART);

    p0_convert(wv, A, lds, G);
    grid.sync();
    const XcdBarrier xbar = xcd_barrier_post((unsigned*)(ws + WS_BAR), bst);
    {
        pg8::Gemm g{X, (const h16*)(ws + WS_WUP1), MT, 2 * DFF, DM}; S.init(MT, 2 * DFF, G, blockIdx.x); S.kt = DM / 64;
        pg8::gemm_phase(wv, lds, g, S, pg8::EpiSwiglu{HP});
        pg8::Gemm g2{(const h16*)(ws + WS_MEMH), (const h16*)(ws + WS_WMKV), 512, 1024, DM}; S.init(512, 1024, G, blockIdx.x); S.kt = DM / 64;
        pg8::gemm_phase(wv, lds, g2, S, pg8::EpiMemKV{A.out, (h16*)(ws + WS_MK16), (h16*)(ws + WS_MVT)});
    }
    xcd_barrier(xbar);
    {
        pg8::Gemm g{HP, (const h16*)(ws + WS_WDN1), MT, DM, DFF}; ST.init(DFF, G, blockIdx.x);
        pg8::gemm_phase(wv, lds, g, ST, pg8::EpiRes{X, DN_ALPHA, 0.5f, PART});
    }
    xcd_barrier(xbar);
    ln_phase(wv, X, A.in[10], A.in[11], nullptr, G, PART, DN_ALPHA, 0.5f);
    xcd_barrier(xbar);
    {
        pg8::Gemm g{X, (const h16*)(ws + WS_WIN), MT, PW, DM}; S.init(MT, PW, G, blockIdx.x); S.kt = DM / 64;
        pg8::gemm_phase(wv, lds, g, S, pg8::EpiProj{HP, A.out, (h16*)(ws + WS_KVC), (h16*)(ws + WS_KIC), ws + WS_KC8, ws + WS_VC8});
    }
    xcd_barrier(xbar);
    gla_prep(wv, A, lds, G);
    xcd_barrier(xbar);
    mixer_phase(wv, A, lds);
    xcd_barrier(xbar);
    gla_out_phase(wv, A, G);
    xcd_barrier(xbar);
    {
        pg8::Gemm g{(const h16*)(ws + WS_MIX), (const h16*)(ws + WS_WO), MT, DM, DM}; ST.init(DM, G, blockIdx.x);
        pg8::gemm_phase(wv, lds, g, ST, pg8::EpiRes{X, DN_ALPHA, 1.f, PART});
    }
    xcd_barrier(xbar);
    ln_phase(wv, X, A.in[10] + DM, A.in[11] + DM, nullptr, G, PART, DN_ALPHA, 1.f);
    xcd_barrier(xbar);
    {
        pg8::Gemm g{X, (const h16*)(ws + WS_WMQ), MT, 512, DM}; S.init(MT, 512, G, blockIdx.x); S.kt = DM / 64;
        pg8::gemm_phase(wv, lds, g, S, pg8::EpiPlain{(h16*)(ws + WS_MQ), 512});
    }
    xcd_barrier(xbar);
    mem_attn_phase(wv, A, lds, G);
    xcd_barrier(xbar);
    {
        pg8::Gemm g{(const h16*)(ws + WS_MO), (const h16*)(ws + WS_WMO), MT, DM, 512}; S.init(MT, DM, G, blockIdx.x); S.kt = 512 / 64;
        pg8::gemm_phase(wv, lds, g, S, pg8::EpiRes{X, DN_ALPHA, 1.f, nullptr});
    }
    xcd_barrier(xbar);
    ln_phase(wv, X, A.in[10] + 2 * DM, A.in[11] + 2 * DM, nullptr, G, nullptr, 0.f, 0.f);
    xcd_barrier(xbar);
    {
        pg8::Gemm g{X, (const h16*)(ws + WS_WUP2), MT, 2 * DFF, DM}; S.init(MT, 2 * DFF, G, blockIdx.x); S.kt = DM / 64;
        pg8::gemm_phase(wv, lds, g, S, pg8::EpiSwiglu{HP});
    }
    xcd_barrier(xbar);
    {
        pg8::Gemm g{HP, (const h16*)(ws + WS_WDN2), MT, DM, DFF}; ST.init(DFF, G, blockIdx.x);
        pg8::gemm_phase(wv, lds, g, ST, pg8::EpiRes{X, DN_ALPHA, 0.5f, PART});
    }
    xcd_barrier(xbar);
    ln_phase(wv, X, A.in[10] + 3 * DM, A.in[11] + 3 * DM, A.out + O_Y, G, PART, DN_ALPHA, 0.5f);
}

extern "C" void kernel_launch(void* const* d_in, const int* in_sizes, int n_in, void* d_out, int out_size, void* d_ws, size_t ws_size, hipStream_t stream) {
    static int grid = 0;
    if (grid == 0) {
        if (n_in != 27 || (size_t)out_size != O_END || ws_size < WS_END) { fprintf(stderr, "kernel_launch: unexpected shapes n_in %d out %d ws %zu\n", n_in, out_size, ws_size); grid = -1; return; }
        int dev = 0, cus = 0, per_cu = 0;
        hipGetDevice(&dev);
        hipDeviceGetAttribute(&cus, hipDeviceAttributeMultiprocessorCount, dev);
        if (hipFuncSetAttribute((const void*)fwd_mega, hipFuncAttributeMaxDynamicSharedMemorySize, LDS_BYTES) != hipSuccess) { fprintf(stderr, "kernel_launch: hipFuncSetAttribute failed\n"); grid = -1; return; }
        hipOccupancyMaxActiveBlocksPerMultiprocessor(&per_cu, (const void*)fwd_mega, 512, LDS_BYTES);
        if (per_cu < 1) { fprintf(stderr, "kernel_launch: occupancy query says %d\n", per_cu); per_cu = 1; }
        (void)hipGetLastError();
        grid = cus * per_cu;
    }
    if (grid < 0) return;
    Args a{};
    for (int i = 0; i < 27; ++i) a.in[i] = (const float*)d_in[i];
    a.out = (float*)d_out; a.ws = (unsigned char*)d_ws;
    void* args[] = {&a};
    hipError_t e = hipLaunchCooperativeKernel((const void*)fwd_mega, dim3(grid), dim3(512), args, LDS_BYTES, stream);
    if (e != hipSuccess) fprintf(stderr, "cooperative launch failed: %s (grid %d)\n", hipGetErrorString(e), grid);
}
```
